# Optimizing an MI355X kernel written in HIP

```python
import jax, jax.numpy as jnp
from jax import lax
import numpy as np

D_MODEL = 1024
BATCH = 8
SEQ = 2048
DEPTH = 1

MEM_LEN = 256
EPS = 1e-6
ATTN_HEADS = 8
ATTN_KV_HEADS = 2
ATTN_HEAD_DIM = 64
ATTN_GROUP = ATTN_HEADS // ATTN_KV_HEADS
WINDOW = 128
ATTN_BLOCK = 128
ROPE_THETA = 10000.0
DN_HEADS = 4
DN_HEAD_K = 128
DN_HEAD_V = 128
DN_CONV = 5
DN_CHUNK = 64
N_DIRS = 2
CROSS_HEADS = 4
CROSS_HEAD_DIM = D_MODEL // CROSS_HEADS
D_FF = -(-8 * D_MODEL // (3 * 256)) * 256
ATTN_WIDTH = ATTN_HEADS * ATTN_HEAD_DIM
DN_WIDTH = DN_HEADS * DN_HEAD_V
MIX_WIDTH = ATTN_WIDTH + DN_WIDTH
DN_QKV = DN_HEADS * (2 * DN_HEAD_K + DN_HEAD_V)
IN_SIZES = [ATTN_WIDTH, ATTN_KV_HEADS * ATTN_HEAD_DIM, ATTN_KV_HEADS * ATTN_HEAD_DIM,
            DN_QKV, DN_WIDTH, N_DIRS * DN_HEADS, N_DIRS * DN_HEADS]
IN_COLS = int(np.sum(IN_SIZES))
IN_SPLITS = [int(v) for v in np.cumsum(IN_SIZES)[:-1]]

kernel_name = 'hybrid_swa_gdn_memory_block'


def _rms_norm(x, gain):
    xf = x.astype(jnp.float32)
    y = xf * lax.rsqrt(jnp.mean(xf * xf, axis=-1, keepdims=True) + EPS)
    return (y * gain.astype(jnp.float32)).astype(x.dtype)


def _l2norm(x):
    return x * lax.rsqrt(jnp.sum(x * x, axis=-1, keepdims=True) + EPS)


def _rope(x, positions):
    half = x.shape[-1] // 2
    inv_freq = ROPE_THETA ** (-jnp.arange(half, dtype=jnp.float32) / half)
    ang = positions.astype(jnp.float32)[..., None] * inv_freq
    cos = jnp.cos(ang)[:, :, None, :]
    sin = jnp.sin(ang)[:, :, None, :]
    xf = x.astype(jnp.float32)
    x1, x2 = xf[..., :half], xf[..., half:]
    return jnp.concatenate([x1 * cos - x2 * sin, x2 * cos + x1 * sin], axis=-1)


def _window_attention(q, k, v, sink):
    b, s = q.shape[0], q.shape[1]
    nb = s // ATTN_BLOCK
    qb = q.reshape(b, nb, ATTN_BLOCK, ATTN_KV_HEADS, ATTN_GROUP, ATTN_HEAD_DIM)

    def band(t):
        tp = t.reshape(b, nb, ATTN_BLOCK, ATTN_KV_HEADS, ATTN_HEAD_DIM)
        tp = jnp.pad(tp, ((0, 0), (1, 1), (0, 0), (0, 0), (0, 0)))
        return jnp.concatenate([tp[:, :-2], tp[:, 1:-1], tp[:, 2:]], axis=2)

    kw, vw = band(k), band(v)
    scores = jnp.einsum('bnqhgd,bnkhd->bnhgqk', qb, kw) * (ATTN_HEAD_DIM ** -0.5)
    qi = jnp.arange(ATTN_BLOCK)[:, None]
    ki = jnp.arange(3 * ATTN_BLOCK)[None, :]
    in_band = jnp.abs(ki - ATTN_BLOCK - qi) <= WINDOW
    kpos = (jnp.arange(nb)[:, None] - 1) * ATTN_BLOCK + jnp.arange(3 * ATTN_BLOCK)[None, :]
    in_seq = (kpos >= 0) & (kpos < s)
    mask = in_band[None, :, :] & in_seq[:, None, :]
    scores = jnp.where(mask[None, :, None, None], scores, -jnp.inf)
    sk = sink.astype(jnp.float32).reshape(ATTN_KV_HEADS, ATTN_GROUP)[None, None, :, :, None, None]
    m = jnp.maximum(jnp.max(scores, axis=-1, keepdims=True), sk)
    p = jnp.exp(scores - m)
    denom = jnp.sum(p, axis=-1, keepdims=True) + jnp.exp(sk - m)
    o = jnp.einsum('bnhgqk,bnkhd->bnqhgd', p / denom, vw)
    return o.reshape(b, s, ATTN_WIDTH)


def _gated_delta_chunked(q, k, v, g, beta):
    b, h, s, dk = q.shape
    dv = v.shape[-1]
    c = DN_CHUNK
    n = s // c
    q = q.reshape(b, h, n, c, dk)
    k = k.reshape(b, h, n, c, dk)
    v = v.reshape(b, h, n, c, dv)
    g = jnp.cumsum(g.reshape(b, h, n, c), axis=-1)
    beta = beta.reshape(b, h, n, c)
    incl = jnp.tril(jnp.ones((c, c), dtype=bool))
    strict = jnp.tril(jnp.ones((c, c), dtype=bool), k=-1)
    decay = jnp.exp(jnp.where(incl, g[..., :, None] - g[..., None, :], -jnp.inf))
    kb = k * beta[..., None]
    lower = jnp.where(strict, jnp.einsum('bhnid,bhnjd->bhnij', kb, k) * decay, 0.0)
    tmat = lower + jnp.eye(c, dtype=jnp.float32)
    rhs = jnp.concatenate([v * beta[..., None], kb * jnp.exp(g)[..., None]], axis=-1)
    sol = lax.linalg.triangular_solve(tmat, rhs, left_side=True, lower=True, unit_diagonal=True)
    u, w = sol[..., :dv], sol[..., dv:]
    qk = jnp.einsum('bhnid,bhnjd->bhnij', q, k) * decay
    qg = q * jnp.exp(g)[..., None]
    kg = k * jnp.exp(g[..., -1:] - g)[..., None]
    g_last = jnp.exp(g[..., -1])

    def step(state, inp):
        qg_i, kg_i, u_i, w_i, qk_i, gl_i = inp
        v_new = u_i - jnp.einsum('bhck,bhkv->bhcv', w_i, state)
        o_i = jnp.einsum('bhck,bhkv->bhcv', qg_i, state) + jnp.einsum('bhij,bhjv->bhiv', qk_i, v_new)
        state = state * gl_i[..., None, None] + jnp.einsum('bhck,bhcv->bhkv', kg_i, v_new)
        return state, o_i

    xs = tuple(jnp.moveaxis(t, 2, 0) for t in (qg, kg, u, w, qk, g_last))
    state0 = jnp.zeros((b, h, dk, dv), jnp.float32)
    _, o = lax.scan(step, state0, xs)
    return jnp.moveaxis(o, 0, 2).reshape(b, h, s, dv)


def _gated_deltanet(qkv, gate, a, bt, conv_w, a_log, dt_bias, g_out):
    b, s = qkv.shape[0], qkv.shape[1]
    ch = qkv.shape[-1]
    pad = DN_CONV // 2
    conv = lax.conv_general_dilated(qkv, conv_w.reshape(DN_CONV, 1, ch).astype(qkv.dtype),
                                    window_strides=(1,), padding=[(pad, pad)],
                                    dimension_numbers=('NWC', 'WIO', 'NWC'), feature_group_count=ch)
    conv = jax.nn.silu(conv.astype(jnp.float32))
    nq = DN_HEADS * DN_HEAD_K
    q = conv[..., :nq].reshape(b, s, DN_HEADS, DN_HEAD_K)
    k = conv[..., nq:2 * nq].reshape(b, s, DN_HEADS, DN_HEAD_K)
    v = conv[..., 2 * nq:].reshape(b, s, DN_HEADS, DN_HEAD_V)
    q = (_l2norm(q) * (DN_HEAD_K ** -0.5)).transpose(0, 2, 1, 3)
    k = _l2norm(k).transpose(0, 2, 1, 3)
    v = v.transpose(0, 2, 1, 3)
    a = a.astype(jnp.float32).reshape(b, s, N_DIRS, DN_HEADS)
    bt = bt.astype(jnp.float32).reshape(b, s, N_DIRS, DN_HEADS)
    g = -jnp.exp(a_log.astype(jnp.float32)) * jax.nn.softplus(a + dt_bias.astype(jnp.float32))
    g = g.transpose(2, 0, 3, 1)
    beta = jax.nn.sigmoid(bt).transpose(2, 0, 3, 1)
    o_fwd = _gated_delta_chunked(q, k, v, g[0], beta[0])
    flip = lambda t: jnp.flip(t, axis=2)
    o_bwd = flip(_gated_delta_chunked(flip(q), flip(k), flip(v), flip(g[1]), flip(beta[1])))
    o = (o_fwd + o_bwd).transpose(0, 2, 1, 3)
    o = o * lax.rsqrt(jnp.mean(o * o, axis=-1, keepdims=True) + EPS) * g_out.astype(jnp.float32)
    o = o * jax.nn.silu(gate.astype(jnp.float32).reshape(b, s, DN_HEADS, DN_HEAD_V))
    return o.reshape(b, s, DN_WIDTH)


def _memory_cross_attention(h, mem_n, w_q, w_kv, w_o):
    b, s = h.shape[0], h.shape[1]
    m = mem_n.shape[1]
    q = (h @ w_q).reshape(b, s, CROSS_HEADS, CROSS_HEAD_DIM).astype(jnp.float32)
    kv = mem_n @ w_kv
    k = kv[..., :D_MODEL].reshape(b, m, CROSS_HEADS, CROSS_HEAD_DIM).astype(jnp.float32)
    v = kv[..., D_MODEL:].reshape(b, m, CROSS_HEADS, CROSS_HEAD_DIM).astype(jnp.float32)
    p = jax.nn.softmax(jnp.einsum('bqhd,bkhd->bhqk', q, k) * (CROSS_HEAD_DIM ** -0.5), axis=-1)
    o = jnp.einsum('bhqk,bkhd->bqhd', p, v).reshape(b, s, D_MODEL).astype(h.dtype)
    return o @ w_o


def _swiglu(h, w_gate_up, w_down):
    gu = h @ w_gate_up
    return (jax.nn.silu(gu[..., :D_FF]) * gu[..., D_FF:]) @ w_down


def setup_inputs(seed: int = 0) -> dict:
    key = jax.random.key(seed)
    ks = jax.random.split(key, 24)
    f32 = jnp.float32

    def dense(k, fan_in, fan_out):
        return jax.random.normal(k, (DEPTH, fan_in, fan_out), f32) * fan_in ** -0.5

    def gain(k, n):
        return 1.0 + 0.02 * jax.random.normal(k, (DEPTH, n), f32)

    x = jax.random.normal(ks[0], (BATCH, SEQ, D_MODEL), f32)
    mem = jax.random.normal(ks[1], (BATCH, MEM_LEN, D_MODEL), f32)
    offsets = jax.random.randint(ks[2], (BATCH, 1), 0, 4096, dtype=jnp.int32)
    positions = jnp.arange(SEQ, dtype=jnp.int32)[None, :] + offsets
    dt = jnp.exp(jax.random.uniform(ks[3], (DEPTH, N_DIRS, DN_HEADS), f32)
                 * (np.log(0.1) - np.log(0.001)) + np.log(0.001))
    return {
        'x': x,
        'mem': mem,
        'positions': positions,
        'g_mix_pre': gain(ks[4], D_MODEL),
        'w_in': dense(ks[5], D_MODEL, IN_COLS),
        'conv_w': jax.random.normal(ks[6], (DEPTH, DN_CONV, DN_QKV), f32) * DN_CONV ** -0.5,
        'a_log': jnp.log(jax.random.uniform(ks[7], (DEPTH, N_DIRS, DN_HEADS), f32, 1.0, 16.0)),
        'dt_bias': dt + jnp.log(-jnp.expm1(-dt)),
        'g_dn_out': gain(ks[8], DN_HEAD_V),
        'attn_sink': 0.5 * jax.random.normal(ks[9], (DEPTH, ATTN_HEADS), f32),
        'w_out': dense(ks[10], MIX_WIDTH, D_MODEL),
        'g_mix_post': gain(ks[11], D_MODEL),
        'g_cross_pre': gain(ks[12], D_MODEL),
        'g_mem': gain(ks[13], D_MODEL),
        'w_cq': dense(ks[14], D_MODEL, D_MODEL),
        'w_ckv': dense(ks[15], D_MODEL, 2 * D_MODEL),
        'w_co': dense(ks[16], D_MODEL, D_MODEL),
        'g_cross_post': gain(ks[17], D_MODEL),
        'g_ffn_pre': gain(ks[18], D_MODEL),
        'w_gate_up': dense(ks[19], D_MODEL, 2 * D_FF),
        'w_down': dense(ks[20], D_FF, D_MODEL),
        'g_ffn_post': gain(ks[21], D_MODEL),
    }


def reference(x, mem, positions, g_mix_pre, w_in, conv_w, a_log, dt_bias, g_dn_out, attn_sink,
              w_out, g_mix_post, g_cross_pre, g_mem, w_cq, w_ckv, w_co, g_cross_post,
              g_ffn_pre, w_gate_up, w_down, g_ffn_post):
    b, s = x.shape[0], x.shape[1]
    for l in range(DEPTH):
        h = _rms_norm(x, g_mix_pre[l])
        proj = h @ w_in[l]
        aq, ak, av, dqkv, dgate, dalpha, dbeta = jnp.split(proj, IN_SPLITS, axis=-1)
        aq = _rope(aq.reshape(b, s, ATTN_HEADS, ATTN_HEAD_DIM), positions)
        ak = _rope(ak.reshape(b, s, ATTN_KV_HEADS, ATTN_HEAD_DIM), positions)
        av = av.reshape(b, s, ATTN_KV_HEADS, ATTN_HEAD_DIM).astype(jnp.float32)
        attn_o = _window_attention(aq, ak, av, attn_sink[l]).astype(x.dtype)
        dn_o = _gated_deltanet(dqkv, dgate, dalpha, dbeta, conv_w[l], a_log[l], dt_bias[l],
                               g_dn_out[l]).astype(x.dtype)
        mix = jnp.concatenate([attn_o, dn_o], axis=-1) @ w_out[l]
        x = x + _rms_norm(mix, g_mix_post[l])
        c = _memory_cross_attention(_rms_norm(x, g_cross_pre[l]), _rms_norm(mem, g_mem[l]),
                                    w_cq[l], w_ckv[l], w_co[l])
        x = x + _rms_norm(c, g_cross_post[l])
        f = _swiglu(_rms_norm(x, g_ffn_pre[l]), w_gate_up[l], w_down[l])
        x = x + _rms_norm(f, g_ffn_post[l])
    return x
```

```cpp
#include <hip/hip_runtime.h>
#include <math.h>
#include <stdint.h>

namespace v1 {
constexpr int B = 8, S = 2048, D = 1024, M = B * S, MEM = 256, MM = B * MEM;
constexpr int INC = 2832, DFF = 2816;
constexpr float EPS = 1e-6f;
constexpr size_t SLOT = (size_t)64 << 20;

__device__ __forceinline__ float wave_sum(float v) {
#pragma unroll
  for (int o = 1; o < 64; o <<= 1) v += __shfl_xor(v, o);
  return v;
}
__device__ __forceinline__ float wave_max(float v) {
#pragma unroll
  for (int o = 1; o < 64; o <<= 1) v = fmaxf(v, __shfl_xor(v, o));
  return v;
}
__device__ __forceinline__ float silu_f(float x) { return x / (1.f + expf(-x)); }

__global__ void __launch_bounds__(256) rmsnorm_k(const float* __restrict__ x, const float* __restrict__ g, float* __restrict__ out) {
  __shared__ float red[4];
  const int row = blockIdx.x, t = threadIdx.x;
  const float4 v = ((const float4*)(x + (size_t)row * D))[t];
  float s = v.x * v.x + v.y * v.y + v.z * v.z + v.w * v.w;
  s = wave_sum(s);
  if ((t & 63) == 0) red[t >> 6] = s;
  __syncthreads();
  const float tot = red[0] + red[1] + red[2] + red[3];
  const float r = rsqrtf(tot * (1.f / D) + EPS);
  const float4 gg = ((const float4*)g)[t];
  float4 o; o.x = v.x * r * gg.x; o.y = v.y * r * gg.y; o.z = v.z * r * gg.z; o.w = v.w * r * gg.w;
  ((float4*)(out + (size_t)row * D))[t] = o;
}
__global__ void __launch_bounds__(256) resnorm_k(const float* base, const float* __restrict__ y, const float* __restrict__ g, float* out) {
  __shared__ float red[4];
  const int row = blockIdx.x, t = threadIdx.x;
  const float4 v = ((const float4*)(y + (size_t)row * D))[t];
  float s = v.x * v.x + v.y * v.y + v.z * v.z + v.w * v.w;
  s = wave_sum(s);
  if ((t & 63) == 0) red[t >> 6] = s;
  __syncthreads();
  const float tot = red[0] + red[1] + red[2] + red[3];
  const float r = rsqrtf(tot * (1.f / D) + EPS);
  const float4 gg = ((const float4*)g)[t];
  const float4 b = ((const float4*)(base + (size_t)row * D))[t];
  float4 o; o.x = b.x + v.x * r * gg.x; o.y = b.y + v.y * r * gg.y; o.z = b.z + v.z * r * gg.z; o.w = b.w + v.w * r * gg.w;
  ((float4*)(out + (size_t)row * D))[t] = o;
}

template <int MODE>
__global__ void __launch_bounds__(256) gemm_k(const float* __restrict__ A, int lda, const float* __restrict__ W, int ldw, float* __restrict__ C, int ldc, int N, int K, int Nhalf) {
  __shared__ float As[16][64 + 4];
  __shared__ float Ws[16][64 + 4];
  __shared__ float Ws2[MODE == 1 ? 16 : 1][64 + 4];
  const int t = threadIdx.x, tx = t & 15, ty = t >> 4;
  const int m0 = blockIdx.y * 64, n0 = blockIdx.x * 64;
  float acc[4][4], acc2[4][4];
#pragma unroll
  for (int i = 0; i < 4; ++i)
#pragma unroll
    for (int j = 0; j < 4; ++j) { acc[i][j] = 0.f; acc2[i][j] = 0.f; }
  for (int k0 = 0; k0 < K; k0 += 16) {
#pragma unroll
    for (int i = 0; i < 4; ++i) { const int e = t + 256 * i, r = e >> 4, kk = e & 15; As[kk][r] = A[(size_t)(m0 + r) * lda + k0 + kk]; }
#pragma unroll
    for (int i = 0; i < 4; ++i) { const int e = t + 256 * i, kk = e >> 6, c = e & 63; const int col = n0 + c;
      Ws[kk][c] = col < N ? W[(size_t)(k0 + kk) * ldw + col] : 0.f;
      if (MODE == 1) Ws2[kk][c] = col < N ? W[(size_t)(k0 + kk) * ldw + col + Nhalf] : 0.f; }
    __syncthreads();
#pragma unroll
    for (int kk = 0; kk < 16; ++kk) {
      float a[4], w[4], w2[4];
#pragma unroll
      for (int i = 0; i < 4; ++i) a[i] = As[kk][ty * 4 + i];
#pragma unroll
      for (int j = 0; j < 4; ++j) { w[j] = Ws[kk][tx * 4 + j]; if (MODE == 1) w2[j] = Ws2[kk][tx * 4 + j]; }
#pragma unroll
      for (int i = 0; i < 4; ++i)
#pragma unroll
        for (int j = 0; j < 4; ++j) { acc[i][j] = fmaf(a[i], w[j], acc[i][j]); if (MODE == 1) acc2[i][j] = fmaf(a[i], w2[j], acc2[i][j]); }
    }
    __syncthreads();
  }
#pragma unroll
  for (int i = 0; i < 4; ++i)
#pragma unroll
    for (int j = 0; j < 4; ++j) { const int col = n0 + tx * 4 + j; if (col < N) {
      float v = acc[i][j]; if (MODE == 1) v = silu_f(v) * acc2[i][j];
      C[(size_t)(m0 + ty * 4 + i) * ldc + col] = v; } }
}

__global__ void __launch_bounds__(320) rope_k(float* proj, const int* __restrict__ positions) {
  const int tok = blockIdx.x, t = threadIdx.x, hh = t >> 5, d = t & 31;
  const float pos = (float)positions[tok];
  const float inv = powf(10000.f, -(float)d / 32.f);
  const float ang = pos * inv;
  const double a = (double)ang * 0.15915494309189535;
  const double fr = a - rint(a);
  const float c = __builtin_amdgcn_cosf((float)fr), s = __builtin_amdgcn_sinf((float)fr);
  float* p = proj + (size_t)tok * INC + hh * 64;
  const float x1 = p[d], x2 = p[d + 32];
  p[d] = x1 * c - x2 * s; p[d + 32] = x2 * c + x1 * s;
}

__global__ void __launch_bounds__(256) wattn_k(const float* __restrict__ proj, const float* __restrict__ sink, float* __restrict__ mix) {
  __shared__ float pbuf[4][320];
  __shared__ float qbuf[4][64];
  const int w = threadIdx.x >> 6, lane = threadIdx.x & 63;
  const int item = blockIdx.x * 4 + w, tok = item >> 3, hq = item & 7, kvh = hq >> 2;
  const int b = tok / S, i = tok % S;
  qbuf[w][lane] = proj[(size_t)tok * INC + hq * 64 + lane];
  __syncthreads();
  const int jlo = i - 128;
  float sc[5]; float mx = sink[hq];
#pragma unroll
  for (int r = 0; r < 5; ++r) {
    const int jj = lane + 64 * r, j = jlo + jj; sc[r] = -INFINITY;
    if (jj <= 256 && j >= 0 && j < S) {
      const float* kp = proj + (size_t)(b * S + j) * INC + 512 + kvh * 64;
      float s = 0.f;
      for (int d = 0; d < 64; ++d) s = fmaf(qbuf[w][d], kp[d], s);
      sc[r] = s * 0.125f; mx = fmaxf(mx, sc[r]);
    }
  }
  mx = wave_max(mx);
  float den = 0.f;
#pragma unroll
  for (int r = 0; r < 5; ++r) { const int jj = lane + 64 * r; const float p = (sc[r] == -INFINITY) ? 0.f : expf(sc[r] - mx); if (jj < 320) pbuf[w][jj] = p; den += p; }
  den = wave_sum(den) + expf(sink[hq] - mx);
  __syncthreads();
  float o = 0.f;
  for (int jj = 0; jj <= 256; ++jj) { const int j = jlo + jj; if (j >= 0 && j < S) o = fmaf(pbuf[w][jj], proj[(size_t)(b * S + j) * INC + 640 + kvh * 64 + lane], o); }
  mix[(size_t)tok * D + hq * 64 + lane] = o / den;
}

__global__ void __launch_bounds__(128) dn_k(const float* __restrict__ proj, const float* __restrict__ conv_w, const float* __restrict__ a_log, const float* __restrict__ dt_bias, float* __restrict__ O) {
  __shared__ __attribute__((aligned(16))) float sk[128];
  __shared__ __attribute__((aligned(16))) float sq[128];
  __shared__ float red[2][2];
  const int j = threadIdx.x, blk = blockIdx.x, dir = blk & 1, h = (blk >> 1) & 3, b = blk >> 3;
  const int cq = 768 + h * 128 + j, ck = cq + 512, cv = cq + 1024;
  float wq[5], wk[5], wv[5];
#pragma unroll
  for (int w = 0; w < 5; ++w) { wq[w] = conv_w[w * 1536 + (cq - 768)]; wk[w] = conv_w[w * 1536 + (ck - 768)]; wv[w] = conv_w[w * 1536 + (cv - 768)]; }
  const float A = -expf(a_log[dir * 4 + h]), dtb = dt_bias[dir * 4 + h];
  float St[128];
#pragma unroll
  for (int i = 0; i < 128; ++i) St[i] = 0.f;
  for (int step = 0; step < S; ++step) {
    const int t = dir ? (S - 1 - step) : step;
    const float* row = proj + (size_t)(b * S + t) * INC;
    float q = 0.f, k = 0.f, v = 0.f;
#pragma unroll
    for (int w = 0; w < 5; ++w) { const int tt = t + w - 2; if (tt >= 0 && tt < S) { const float* r2 = proj + (size_t)(b * S + tt) * INC; q = fmaf(r2[cq], wq[w], q); k = fmaf(r2[ck], wk[w], k); v = fmaf(r2[cv], wv[w], v); } }
    q = silu_f(q); k = silu_f(k); v = silu_f(v);
    const float av = row[2816 + dir * 4 + h] + dtb, bt = row[2824 + dir * 4 + h];
    const float sp = av > 20.f ? av : log1pf(expf(av));
    const float e = expf(A * sp), beta = 1.f / (1.f + expf(-bt));
    float s1 = wave_sum(q * q), s2 = wave_sum(k * k);
    if ((j & 63) == 0) { red[j >> 6][0] = s1; red[j >> 6][1] = s2; }
    __syncthreads();
    const float ssq = red[0][0] + red[1][0], ssk = red[0][1] + red[1][1];
    sq[j] = q * rsqrtf(ssq + EPS) * 0.08838834764831845f; sk[j] = k * rsqrtf(ssk + EPS);
    __syncthreads();
    float dot = 0.f;
#pragma unroll
    for (int i4 = 0; i4 < 32; ++i4) { const float4 kk = ((const float4*)sk)[i4]; dot = fmaf(kk.x, St[4 * i4], dot); dot = fmaf(kk.y, St[4 * i4 + 1], dot); dot = fmaf(kk.z, St[4 * i4 + 2], dot); dot = fmaf(kk.w, St[4 * i4 + 3], dot); }
    const float c = beta * (v - e * dot);
    float o = 0.f;
#pragma unroll
    for (int i4 = 0; i4 < 32; ++i4) { const float4 kk = ((const float4*)sk)[i4]; const float4 qq = ((const float4*)sq)[i4];
      St[4 * i4] = fmaf(e, St[4 * i4], kk.x * c); o = fmaf(qq.x, St[4 * i4], o);
      St[4 * i4 + 1] = fmaf(e, St[4 * i4 + 1], kk.y * c); o = fmaf(qq.y, St[4 * i4 + 1], o);
      St[4 * i4 + 2] = fmaf(e, St[4 * i4 + 2], kk.z * c); o = fmaf(qq.z, St[4 * i4 + 2], o);
      St[4 * i4 + 3] = fmaf(e, St[4 * i4 + 3], kk.w * c); o = fmaf(qq.w, St[4 * i4 + 3], o); }
    O[((size_t)dir * M + (size_t)(b * S + t)) * 512 + h * 128 + j] = o;
  }
}
__global__ void __launch_bounds__(128) dn_combine_k(const float* __restrict__ O, const float* __restrict__ proj, const float* __restrict__ g_out, float* __restrict__ mix) {
  __shared__ float red[2];
  const int tok = blockIdx.x >> 2, h = blockIdx.x & 3, j = threadIdx.x;
  const float o = O[(size_t)tok * 512 + h * 128 + j] + O[((size_t)M + tok) * 512 + h * 128 + j];
  const float s = wave_sum(o * o);
  if ((j & 63) == 0) red[j >> 6] = s;
  __syncthreads();
  const float r = rsqrtf((red[0] + red[1]) * (1.f / 128.f) + EPS);
  const float gate = proj[(size_t)tok * INC + 2304 + h * 128 + j];
  mix[(size_t)tok * D + 512 + h * 128 + j] = o * r * g_out[j] * silu_f(gate);
}
__global__ void __launch_bounds__(256) cattn_k(const float* __restrict__ q, const float* __restrict__ kv, float* __restrict__ o) {
  __shared__ float qb[4][256];
  __shared__ float pb[4][256];
  const int w = threadIdx.x >> 6, lane = threadIdx.x & 63;
  const int item = blockIdx.x * 4 + w, tok = item >> 2, hd = item & 3, b = tok / S;
  for (int i = 0; i < 4; ++i) qb[w][lane + 64 * i] = q[(size_t)tok * D + hd * 256 + lane + 64 * i];
  __syncthreads();
  float sc[4], mx = -INFINITY;
#pragma unroll
  for (int r = 0; r < 4; ++r) { const int key = lane + 64 * r; const float* kp = kv + (size_t)(b * MEM + key) * 2048 + hd * 256; float s = 0.f;
    for (int d = 0; d < 256; ++d) s = fmaf(qb[w][d], kp[d], s);
    sc[r] = s * 0.0625f; mx = fmaxf(mx, sc[r]); }
  mx = wave_max(mx);
  float den = 0.f;
#pragma unroll
  for (int r = 0; r < 4; ++r) { const float p = expf(sc[r] - mx); pb[w][lane + 64 * r] = p; den += p; }
  den = wave_sum(den);
  __syncthreads();
  float acc[4] = {0.f, 0.f, 0.f, 0.f};
  for (int key = 0; key < 256; ++key) { const float p = pb[w][key]; const float* vp = kv + (size_t)(b * MEM + key) * 2048 + 1024 + hd * 256;
#pragma unroll
    for (int r = 0; r < 4; ++r) acc[r] = fmaf(p, vp[lane + 64 * r], acc[r]); }
#pragma unroll
  for (int r = 0; r < 4; ++r) o[(size_t)tok * D + hd * 256 + lane + 64 * r] = acc[r] / den;
}

static void run(void* const* d_in, void* d_out, void* d_ws, hipStream_t st) {
  const float* x = (const float*)d_in[0]; const float* mem = (const float*)d_in[1]; const int* positions = (const int*)d_in[2];
  const float* g_mix_pre = (const float*)d_in[3]; const float* w_in = (const float*)d_in[4]; const float* conv_w = (const float*)d_in[5];
  const float* a_log = (const float*)d_in[6]; const float* dt_bias = (const float*)d_in[7]; const float* g_dn_out = (const float*)d_in[8];
  const float* attn_sink = (const float*)d_in[9]; const float* w_out = (const float*)d_in[10]; const float* g_mix_post = (const float*)d_in[11];
  const float* g_cross_pre = (const float*)d_in[12]; const float* g_mem = (const float*)d_in[13]; const float* w_cq = (const float*)d_in[14];
  const float* w_ckv = (const float*)d_in[15]; const float* w_co = (const float*)d_in[16]; const float* g_cross_post = (const float*)d_in[17];
  const float* g_ffn_pre = (const float*)d_in[18]; const float* w_gate_up = (const float*)d_in[19]; const float* w_down = (const float*)d_in[20];
  const float* g_ffn_post = (const float*)d_in[21];
  float* out = (float*)d_out; char* ws = (char*)d_ws;
  float* S0 = (float*)(ws); float* S1 = (float*)(ws + SLOT); float* S2 = (float*)(ws + 2 * SLOT); float* S3 = (float*)(ws + 3 * SLOT);
  float* proj = S0; float* mix = S3;
  rmsnorm_k<<<M, 256, 0, st>>>(x, g_mix_pre, out);
  gemm_k<0><<<dim3((INC + 63) / 64, M / 64), 256, 0, st>>>(out, D, w_in, INC, proj, INC, INC, D, 0);
  rope_k<<<M, 320, 0, st>>>(proj, positions);
  wattn_k<<<M * 8 / 4, 256, 0, st>>>(proj, attn_sink, mix);
  dn_k<<<64, 128, 0, st>>>(proj, conv_w, a_log, dt_bias, out);
  dn_combine_k<<<M * 4, 128, 0, st>>>(out, proj, g_dn_out, mix);
  gemm_k<0><<<dim3(D / 64, M / 64), 256, 0, st>>>(mix, D, w_out, D, S0, D, D, D, 0);
  resnorm_k<<<M, 256, 0, st>>>(x, S0, g_mix_post, out);
  rmsnorm_k<<<M, 256, 0, st>>>(out, g_cross_pre, S1);
  gemm_k<0><<<dim3(D / 64, M / 64), 256, 0, st>>>(S1, D, w_cq, D, S2, D, D, D, 0);
  float* memn = S0; float* kv = S0 + (size_t)MM * D;
  rmsnorm_k<<<MM, 256, 0, st>>>(mem, g_mem, memn);
  gemm_k<0><<<dim3(2048 / 64, MM / 64), 256, 0, st>>>(memn, D, w_ckv, 2048, kv, 2048, 2048, D, 0);
  cattn_k<<<M * 4 / 4, 256, 0, st>>>(S2, kv, S3);
  gemm_k<0><<<dim3(D / 64, M / 64), 256, 0, st>>>(S3, D, w_co, D, S1, D, D, D, 0);
  resnorm_k<<<M, 256, 0, st>>>(out, S1, g_cross_post, out);
  rmsnorm_k<<<M, 256, 0, st>>>(out, g_ffn_pre, S3);
  gemm_k<1><<<dim3(DFF / 64, M / 64), 256, 0, st>>>(S3, D, w_gate_up, 2 * DFF, S0, DFF, DFF, D, DFF);
  gemm_k<0><<<dim3(D / 64, M / 64), 256, 0, st>>>(S0, DFF, w_down, D, S3, D, D, DFF, 0);
  resnorm_k<<<M, 256, 0, st>>>(out, S3, g_ffn_post, out);
}
}

extern "C" void kernel_launch(void* const* d_in, const int* in_sizes, int n_in, void* d_out, int out_size, void* d_ws, size_t ws_size, hipStream_t stream) {
  v1::run(d_in, d_out, d_ws, stream);
}
```

```cpp
#include <hip/hip_runtime.h>
#include <cstdio>
#include <cstdint>
#include <math.h>
namespace pg8 {
#define PG8_LAS __attribute__((address_space(3)))
typedef unsigned short bf16_t;
typedef short bf16x8 __attribute__((ext_vector_type(8)));
typedef float f32x4 __attribute__((ext_vector_type(4)));
typedef unsigned u32x4 __attribute__((ext_vector_type(4)));
constexpr int BM = 256, BK = 64, HALF = 128, HTB = HALF * BK * 2  , STAGE_BYTES = 8 * HTB, NXCD = 8, WGM = 8;

__host__ __device__ __forceinline__ int lds_byte(int r, int c) { const int st = (r >> 4) * 2 + (c >> 5), rr = r & 15, cc = c & 31, ob = rr * 64 + cc * 2; return st * 1024 + (ob ^ (((ob >> 9) & 1) << 5)); }
__host__ __device__ __forceinline__ void stage_rc(int b, int& R, int& C) { const int st = b / 1024, sb = b % 1024, swz = sb ^ (((sb >> 9) & 1) << 5); R = (st >> 1) * 16 + swz / 64; C = (st & 1) * 32 + (swz % 64) / 2; }
__host__ __device__ __forceinline__ int perm32(int rho) { const int n = rho >> 4, i = rho & 15; return 8 * (i >> 2) + 4 * n + (i & 3); }

struct Unit { int pm, pn; };
struct Gemm { const bf16_t* A; const bf16_t* Bt; int M, N, K; };

struct StaticOrder {
    int nM, nN, nwg, G, c;
    __host__ __device__ void init(int M, int N, int G_, int c_) { nM = M / BM; nN = N / BM; nwg = nM * nN; G = G_; c = c_; }
    __host__ __device__ bool next(int i, Unit& u) const {
        const long L = (long)i * G + c; if (L >= nwg) return false;
        int wgid = (int)L; { const int q = nwg / NXCD, r = nwg % NXCD, xcd = wgid % NXCD, off = wgid / NXCD; wgid = (xcd < r ? xcd * (q + 1) : r * (q + 1) + (xcd - r) * q) + off; }
        const int nig = WGM * nN, gid = wgid / nig, fm = gid * WGM, gsz = (nM - fm) < WGM ? (nM - fm) : WGM;
        u.pm = fm + ((wgid % nig) % gsz); u.pn = (wgid % nig) / gsz; return true;
    }
    __device__ __forceinline__ void a_ready(const Unit&) const {}
    __device__ __forceinline__ void done(const Unit&) const {}
};

__device__ __forceinline__ unsigned cvt_pk_bf16(float lo, float hi) { unsigned r; asm volatile("v_cvt_pk_bf16_f32 %0, %1, %2" : "=v"(r) : "v"(lo), "v"(hi)); return r; }
template <class Epi, class Sched, bool ALIGN_EPI = false, bool SP2 = false>
__device__ __forceinline__ void gemm_phase(PG8_LAS unsigned char* lds, const Gemm g, const Sched& S, const Epi& E) {
    const int tid = threadIdx.x, wid = __builtin_amdgcn_readfirstlane(tid >> 6), lane = tid & 63, wr = wid >> 2, wc = wid & 3, fr = lane & 15, fq = lane >> 4;
    const int K = g.K, nt = K / BK;
    unsigned voffA[2], voffB[2];
#pragma unroll
    for (int i = 0; i < 2; ++i) { int R, C; stage_rc(tid * 16 + i * 8192, R, C); const int Rb = Epi::PERM ? ((R & ~31) + perm32(R & 31)) : R;
        voffA[i] = (unsigned)(R * K + C) * 2u; voffB[i] = (unsigned)(Rb * K + C) * 2u; }
    const size_t kstep = (size_t)(BK * 2);
    const size_t hstep = (size_t)HALF * K * 2;
    const size_t tstep = 2 * hstep;
    const unsigned ldsw = (unsigned)wid * 1024u;
    const int aoff = lds_byte(wr * 64 + fr, fq * 8), boff = lds_byte(wc * 32 + fr, fq * 8);
#define PG8_SA(b, h) (((b) * 2 + (h)) * HTB)
#define PG8_SB(b, h) ((4 + (b) * 2 + (h)) * HTB)
#define PG8_STAGE(bufoff, gbase, voff) do { _Pragma("unroll") for (int _i = 0; _i < 2; ++_i) \
        __builtin_amdgcn_global_load_lds((const unsigned*)((const char*)(gbase) + (voff)[_i]), (PG8_LAS unsigned*)(lds + (bufoff) + ldsw + _i * 8192), 16, 0, 0); } while (0)
#define PG8_LDA(dst, b, h) do { _Pragma("unroll") for (int m = 0; m < 4; ++m) _Pragma("unroll") for (int k = 0; k < 2; ++k) dst[m][k] = *(const PG8_LAS bf16x8*)(lds + PG8_SA(b, h) + aoff + m * 2048 + k * 1024); } while (0)
#define PG8_LDB(dst, b, h) do { _Pragma("unroll") for (int n = 0; n < 2; ++n) _Pragma("unroll") for (int k = 0; k < 2; ++k) dst[n][k] = *(const PG8_LAS bf16x8*)(lds + PG8_SB(b, h) + boff + n * 2048 + k * 1024); } while (0)
#define PG8_MMA(ai, bj, At, Bt) do { __builtin_amdgcn_s_setprio(1); _Pragma("unroll") for (int m = 0; m < 4; ++m) _Pragma("unroll") for (int n = 0; n < 2; ++n) _Pragma("unroll") for (int k = 0; k < 2; ++k) \
        acc[ai][bj][m][n] = __builtin_amdgcn_mfma_f32_16x16x32_bf16(Bt[n][k], At[m][k], acc[ai][bj][m][n], 0, 0, 0); __builtin_amdgcn_s_setprio(0); } while (0)
#define PG8_WAIT_V(n) asm volatile("s_waitcnt vmcnt(" #n ")" ::: "memory")
#define PG8_WAIT_L(n) asm volatile("s_waitcnt lgkmcnt(" #n ")" ::: "memory")
#define PG8_BAR __builtin_amdgcn_s_barrier()
#define PG8_SCHED __builtin_amdgcn_sched_barrier(0)
    Unit cur, nxt; int ui = 0;
    if (!S.next(0, cur)) return;
    f32x4 acc[2][2][4][2];
#pragma unroll
    for (int a = 0; a < 2; ++a)
#pragma unroll
        for (int b = 0; b < 2; ++b)
#pragma unroll
            for (int m = 0; m < 4; ++m)
#pragma unroll
                for (int n = 0; n < 2; ++n) acc[a][b][m][n] = (f32x4){0.f, 0.f, 0.f, 0.f};
    bf16x8 At[4][2], B0[2][2], B1[2][2];
    const char* cA = (const char*)g.A + (size_t)cur.pm * tstep; const char* cB = (const char*)g.Bt + (size_t)cur.pn * tstep;
    S.a_ready(cur);
    if constexpr (SP2) {
        PG8_STAGE(PG8_SB(0, 0), cB, voffB); PG8_STAGE(PG8_SB(0, 1), cB + hstep, voffB); PG8_STAGE(PG8_SA(0, 0), cA, voffA); PG8_STAGE(PG8_SA(0, 1), cA + hstep, voffA);
        if (wr == 1) PG8_BAR;
        PG8_WAIT_V(2); PG8_BAR;
        PG8_STAGE(PG8_SB(1, 0), cB + kstep, voffB); PG8_STAGE(PG8_SA(1, 0), cA + kstep, voffA); PG8_STAGE(PG8_SB(1, 1), cB + hstep + kstep, voffB);
        PG8_WAIT_V(6); PG8_BAR;
    } else {
        PG8_STAGE(PG8_SB(0, 0), cB, voffB); PG8_STAGE(PG8_SA(0, 0), cA, voffA); PG8_STAGE(PG8_SB(0, 1), cB + hstep, voffB); PG8_STAGE(PG8_SA(0, 1), cA + hstep, voffA);
        if (wr == 1) PG8_BAR;
        PG8_WAIT_V(4); PG8_BAR;
        PG8_STAGE(PG8_SB(1, 0), cB + kstep, voffB); PG8_STAGE(PG8_SA(1, 0), cA + kstep, voffA); PG8_STAGE(PG8_SB(1, 1), cB + hstep + kstep, voffB);
        PG8_WAIT_V(6); PG8_BAR;
    }
    for (;;) {
        const bool has_next = S.next(ui + 1, nxt);
        const char* nA = has_next ? (const char*)g.A + (size_t)nxt.pm * tstep : cA; const char* nB = has_next ? (const char*)g.Bt + (size_t)nxt.pn * tstep : cB;
        for (int t = 0; t < nt; t += 2) {
            const bool last = (t == nt - 2);
            const char* a1 = cA + (size_t)(t + 1) * kstep;
            const char* a2 = last ? nA : cA + (size_t)(t + 2) * kstep; const char* b2 = last ? nB : cB + (size_t)(t + 2) * kstep;
            const char* a3 = a2 + kstep; const char* b3 = b2 + kstep;
            if (last && has_next) S.a_ready(nxt);
            if constexpr (SP2) {
            PG8_LDB(B0, 0, 0); PG8_LDB(B1, 0, 1); PG8_SCHED; PG8_LDA(At, 0, 0); PG8_STAGE(PG8_SA(1, 1), a1 + hstep, voffA);
            PG8_WAIT_V(8); PG8_WAIT_L(0); PG8_BAR; PG8_MMA(0, 0, At, B0); PG8_MMA(0, 1, At, B1); PG8_BAR; PG8_SCHED;
            PG8_LDA(At, 0, 1); PG8_STAGE(PG8_SB(0, 0), b2, voffB); PG8_STAGE(PG8_SB(0, 1), b2 + hstep, voffB); PG8_STAGE(PG8_SA(0, 0), a2, voffA);
            PG8_WAIT_V(8); PG8_WAIT_L(0); PG8_BAR; PG8_MMA(1, 0, At, B0); PG8_MMA(1, 1, At, B1); PG8_BAR; PG8_SCHED;
            PG8_LDB(B0, 1, 0); PG8_LDB(B1, 1, 1); PG8_SCHED; PG8_LDA(At, 1, 0); PG8_STAGE(PG8_SA(0, 1), a2 + hstep, voffA);
            PG8_WAIT_V(8); PG8_WAIT_L(0); PG8_BAR; PG8_MMA(0, 0, At, B0); PG8_MMA(0, 1, At, B1); PG8_BAR; PG8_SCHED;
            PG8_LDA(At, 1, 1); PG8_STAGE(PG8_SB(1, 0), b3, voffB); PG8_STAGE(PG8_SB(1, 1), b3 + hstep, voffB); PG8_STAGE(PG8_SA(1, 0), a3, voffA);
            PG8_WAIT_V(8); PG8_WAIT_L(0); PG8_BAR; PG8_MMA(1, 0, At, B0); PG8_MMA(1, 1, At, B1); PG8_BAR; PG8_SCHED;
            } else {
            PG8_LDB(B0, 0, 0); PG8_SCHED; PG8_LDA(At, 0, 0); PG8_STAGE(PG8_SA(1, 1), a1 + hstep, voffA);
            PG8_WAIT_L(8); PG8_BAR; PG8_WAIT_L(0); PG8_MMA(0, 0, At, B0); PG8_BAR; PG8_SCHED;
            PG8_LDB(B1, 0, 1); PG8_STAGE(PG8_SB(0, 0), b2, voffB);
            PG8_BAR; PG8_WAIT_L(0); PG8_MMA(0, 1, At, B1); PG8_BAR;
            PG8_LDA(At, 0, 1); PG8_STAGE(PG8_SA(0, 0), a2, voffA);
            PG8_BAR; PG8_WAIT_L(0); PG8_MMA(1, 0, At, B0); PG8_BAR; PG8_SCHED;
            PG8_STAGE(PG8_SB(0, 1), b2 + hstep, voffB);
            PG8_WAIT_V(6); PG8_BAR; PG8_MMA(1, 1, At, B1); PG8_BAR;
            PG8_LDB(B0, 1, 0); PG8_SCHED; PG8_LDA(At, 1, 0); PG8_STAGE(PG8_SA(0, 1), a2 + hstep, voffA);
            PG8_WAIT_L(8); PG8_BAR; PG8_WAIT_L(0); PG8_MMA(0, 0, At, B0); PG8_BAR; PG8_SCHED;
            PG8_LDB(B1, 1, 1); PG8_STAGE(PG8_SB(1, 0), b3, voffB);
            PG8_BAR; PG8_WAIT_L(0); PG8_MMA(0, 1, At, B1); PG8_BAR;
            PG8_LDA(At, 1, 1); PG8_STAGE(PG8_SA(1, 0), a3, voffA);
            PG8_BAR; PG8_WAIT_L(0); PG8_MMA(1, 0, At, B0); PG8_BAR; PG8_SCHED;
            PG8_STAGE(PG8_SB(1, 1), b3 + hstep, voffB);
            PG8_WAIT_V(6); PG8_BAR; PG8_MMA(1, 1, At, B1); PG8_BAR;
            }
        }
        if constexpr (ALIGN_EPI) { if (wr == 0) PG8_BAR; }
        if constexpr (!Epi::AFTER_DRAIN) { E(acc, cur, wr, wc, fr, fq); S.done(cur); }
        if (!has_next) break;
#pragma unroll
        for (int a = 0; a < 2; ++a)
#pragma unroll
            for (int b = 0; b < 2; ++b)
#pragma unroll
                for (int m = 0; m < 4; ++m)
#pragma unroll
                    for (int n = 0; n < 2; ++n) acc[a][b][m][n] = (f32x4){0.f, 0.f, 0.f, 0.f};
        cur = nxt; cA = nA; cB = nB; ++ui;
        if constexpr (ALIGN_EPI) { if (wr == 1) PG8_BAR; }
    }
    PG8_WAIT_V(0);
    if constexpr (!ALIGN_EPI) { if (wr == 0) PG8_BAR; }
    PG8_BAR;
    if constexpr (Epi::AFTER_DRAIN) { E.fused(acc, cur, wr, wc, fr, fq, lds, wid, lane); S.done(cur); }
#undef PG8_SA
#undef PG8_SB
#undef PG8_STAGE
#undef PG8_LDA
#undef PG8_LDB
#undef PG8_MMA
#undef PG8_WAIT_V
#undef PG8_WAIT_L
#undef PG8_BAR
#undef PG8_SCHED
}
}
#define GAS __attribute__((address_space(1)))
#define LAS __attribute__((address_space(3)))
typedef unsigned short bf16;
typedef unsigned v4u __attribute__((ext_vector_type(4))); typedef unsigned v2u __attribute__((ext_vector_type(2)));
typedef float f32x4 __attribute__((ext_vector_type(4)));
typedef short bf16x8 __attribute__((ext_vector_type(8)));
typedef GAS unsigned gu32;
typedef GAS unsigned long long gu64;
#define RLX_AGENT __ATOMIC_RELAXED, __HIP_MEMORY_SCOPE_AGENT
#define LDS_WAIT() asm volatile("s_waitcnt lgkmcnt(0)" ::: "memory")
#define VM_WAIT() asm volatile("s_waitcnt vmcnt(0)" ::: "memory")
__device__ __forceinline__ unsigned long long rt() { return __builtin_amdgcn_s_memrealtime(); }
__device__ __forceinline__ unsigned f2bf(float f) { unsigned u = __builtin_bit_cast(unsigned, f); return (u + 0x7fffu + ((u >> 16) & 1u)) >> 16; }
__device__ __forceinline__ unsigned pk2(float lo, float hi) { return f2bf(lo) | (f2bf(hi) << 16); }

#define XB_TMO      128
#define XB_XCNT(j)  (256  + 64 * (j))
#define XB_XSUB(j)  (1280 + 64 * (j))
#define XB_XGEN(j)  (2304 + 64 * (j))
#define XB_TOP      3328
#define XB_TOPGEN   3392
#define XCD_BAR_WORDS 3456
#define XB_SPIN_CAP (1u << 18)

__device__ __forceinline__ unsigned xb_ld(unsigned* p)              { return __hip_atomic_load(p, __ATOMIC_RELAXED, __HIP_MEMORY_SCOPE_AGENT); }
__device__ __forceinline__ unsigned xb_add(unsigned* p, unsigned v) { return __hip_atomic_fetch_add(p, v, __ATOMIC_RELAXED, __HIP_MEMORY_SCOPE_AGENT); }
__device__ __forceinline__ unsigned xb_xcc_id() { return (unsigned)__builtin_amdgcn_s_getreg((3 << 11) | 20) & 0xFu; }
#define XB_SPIN(cond, bar) do { unsigned _sp = 0; while (cond) { __builtin_amdgcn_s_sleep(1); \
    if ((++_sp & 255u) == 0u) { if (xb_ld(&(bar)[XB_TMO])) break; if (_sp > XB_SPIN_CAP) { atomicAdd(&(bar)[XB_TMO], 1u); break; } } } } while (0)

struct XcdBarrier {
    unsigned* bar; unsigned x;
    volatile LAS unsigned* st;
};

__device__ __forceinline__ XcdBarrier xcd_barrier_post(unsigned* bar, volatile LAS unsigned* st) {
    XcdBarrier b; b.bar = bar; b.x = xb_xcc_id(); b.st = st;
    if (threadIdx.x == 0) (void)xb_add(&bar[XB_XCNT(b.x)], 1u);
    return b;
}
__device__ __forceinline__ void xcd_barrier_complete(unsigned* bar, unsigned x, unsigned& nloc, unsigned& nx) {
    const unsigned G = gridDim.x * gridDim.y * gridDim.z;
    unsigned sum, cnt, mine, sp = 0u;
    for (;;) {
        sum = 0u; cnt = 0u; mine = 0u;
#pragma unroll
        for (unsigned j = 0; j < 16; ++j) { const unsigned c = xb_ld(&bar[XB_XCNT(j)]); sum += c; cnt += (c > 0u) ? 1u : 0u; mine = (j == x) ? c : mine; }
        if (sum == G) break;
        __builtin_amdgcn_s_sleep(1);
        if ((++sp & 255u) == 0u) { if (xb_ld(&bar[XB_TMO])) break; if (sp > XB_SPIN_CAP) { atomicAdd(&bar[XB_TMO], 1u); break; } }
    }
    nloc = mine > 0u ? mine : 1u; nx = cnt > 0u ? cnt : 1u;
}

__device__ __forceinline__ void xcd_barrier(const XcdBarrier& b) {
    asm volatile("s_waitcnt vmcnt(0)" ::: "memory");
    __syncthreads();
    if (threadIdx.x == 0) {
        unsigned* bar = b.bar;
        __builtin_amdgcn_s_waitcnt(0);
        unsigned nloc = b.st[0], nx = b.st[1];
        if (nloc == 0u) { xcd_barrier_complete(bar, b.x, nloc, nx); b.st[0] = nloc; b.st[1] = nx; }
        const unsigned old = xb_add(&bar[XB_XSUB(b.x)], 1u);
        const unsigned gen = old / nloc;
        if (old + 1u == (gen + 1u) * nloc) {
            __builtin_amdgcn_fence(__ATOMIC_RELEASE, "agent");
            asm volatile("s_waitcnt vmcnt(0)" ::: "memory");
            const unsigned og = xb_add(&bar[XB_TOP], 1u);
            const unsigned tg = og / nx;
            if (og + 1u == (tg + 1u) * nx) xb_add(&bar[XB_TOPGEN], 1u);
            else XB_SPIN(xb_ld(&bar[XB_TOPGEN]) == tg, bar);
            __builtin_amdgcn_fence(__ATOMIC_ACQUIRE, "agent");
            xb_add(&bar[XB_XGEN(b.x)], 1u);
            asm volatile("s_waitcnt vmcnt(0)" ::: "memory");
        } else {
            XB_SPIN(xb_ld(&bar[XB_XGEN(b.x)]) == gen, bar);
            __builtin_amdgcn_fence(__ATOMIC_ACQUIRE, "agent");
            asm volatile("s_waitcnt vmcnt(0)" ::: "memory");
        }
    }
    __syncthreads();
}
constexpr int NWAVES = 8;
constexpr int BATCH = 8, SEQ = 2048, D = 1024, M = BATCH * SEQ, MEMLEN = 256, MMEM = BATCH * MEMLEN;
constexpr int INC = 2832, DFF = 2816;
constexpr float EPS = 1e-6f;
constexpr float LOG2E = 1.4426950408889634f;
constexpr float QSCALE_A = 0.125f * LOG2E;
constexpr float QSCALE_C = 0.0625f * LOG2E;
constexpr size_t MiB = (size_t)1 << 20;
constexpr size_t WS_CTL = 0, CTL_ZERO_BYTES = 1 * MiB;
constexpr size_t WS_GB = 1 * MiB;
constexpr size_t WS_WOUT = 2 * MiB, WS_WCQ = 4 * MiB, WS_WCO = 6 * MiB, WS_WGU = 8 * MiB, WS_WDOWN = 19 * MiB;
constexpr size_t WS_ROPE = 25 * MiB;
constexpr size_t WS_KC = 29 * MiB, WS_VCT = 33 * MiB;
constexpr size_t WS_DGATE = 37 * MiB;
constexpr size_t WS_QA = 53 * MiB, WS_KA = 69 * MiB, WS_VA = 73 * MiB;
constexpr size_t WS_DQKV = 77 * MiB;
constexpr size_t WS_MIX = 125 * MiB;
constexpr size_t WS_REG1 = 157 * MiB;
constexpr int R1_XN = 0, R1_MEMN = 16384, R1_WIN = 18432, R1_WK = 21248, R1_WV = 22272, R1_ROWS = 23296;
constexpr int T_MEMN = R1_MEMN / 256, T_WIN = R1_WIN / 256, T_WK = R1_WK / 256, T_WV = R1_WV / 256;
constexpr size_t WS_PREPB = 157 * MiB;
#ifndef DEV_OFB
#define DEV_OFB 0
#endif
constexpr size_t WS_OFB = (DEV_OFB ? 205 : 53) * MiB;
constexpr size_t WS_MIXO = 85 * MiB;
constexpr size_t WS_QC = 53 * MiB, WS_OC = 85 * MiB, WS_CC = 117 * MiB;
constexpr size_t WS_ACT = 37 * MiB;
constexpr size_t WS_FF = 125 * MiB;
constexpr size_t WS_END = 256 * MiB;
constexpr int CW_TMO = 0, CW_BAR = 4096;
constexpr int RING_OFF = 0, RING_BYTES = 131072;
constexpr int LDSCTL_OFF = 147456 - 512, MISC_OFF = LDSCTL_OFF + 320;
constexpr int LDS_BYTES = 147456;
struct Args { const void* in[22]; float* out; unsigned char* ws; int ph_lo, ph_hi; };
struct Frame {
    LAS unsigned char* lds; volatile LAS unsigned* MISC; gu32* ctl;
    int tid, lane, wave, vcu, G;
    unsigned char* ws; float* out;
};
__device__ __forceinline__ float wave_sum(float v) {
#pragma unroll
    for (int o = 1; o < 64; o <<= 1) v += __shfl_xor(v, o);
    return v;
}
__device__ __forceinline__ float silu_f(float x) { return x / (1.f + __expf(-x)); }
__device__ __forceinline__ float bf2f(unsigned short b) { return __uint_as_float((unsigned)b << 16); }
__device__ __forceinline__ float bflo(unsigned w) { return __uint_as_float(w << 16); }
__device__ __forceinline__ float bfhi(unsigned w) { return __uint_as_float(w & 0xffff0000u); }

__device__ __forceinline__ void p0_transpose_item(const float* W, int ldw, const float* gain, bf16* WT, int ldt, int k0, int n0, int dst_row, LAS float* scr, int lane) {
#pragma unroll 8
    for (int i = 0; i < 32; ++i) { const int kk = 2 * i + (lane >> 5); const float gv = gain ? gain[k0 + kk] : 1.f; scr[kk * 33 + (lane & 31)] = W[(size_t)(k0 + kk) * ldw + n0 + (lane & 31)] * gv; }
    LDS_WAIT(); asm volatile("" ::: "memory");
    const int c = lane & 7;
#pragma unroll
    for (int j = 0; j < 4; ++j) { const int n = (lane >> 3) + 8 * j; const LAS float* s = scr + (8 * c) * 33 + n;
        v4u o; o.x = pk2(s[0 * 33], s[1 * 33]); o.y = pk2(s[2 * 33], s[3 * 33]); o.z = pk2(s[4 * 33], s[5 * 33]); o.w = pk2(s[6 * 33], s[7 * 33]);
        *(GAS v4u*)(WT + (size_t)(dst_row + n) * ldt + k0 + 8 * c) = o; }
    LDS_WAIT(); asm volatile("" ::: "memory");
}
__device__ __forceinline__ int map_win(int n0) {
    if (n0 < 512) { const int hq = n0 >> 6, half = (n0 >> 5) & 1; return (hq >> 2) * 256 + half * 128 + (hq & 3) * 32; }
    if (n0 < 640) { const int c = n0 - 512, kh = c >> 6, half = (c >> 5) & 1; return 512 + half * 128 + kh * 32; }
    if (n0 < 768) { const int c = n0 - 640; return 512 + (c >> 6) * 128 + 64 + (c & 63); }
    return n0;
}
__device__ __forceinline__ int map_gu(int n0) { if (n0 < DFF) return (n0 >> 7) * 256 + (n0 & 127); const int j = n0 - DFF; return (j >> 7) * 256 + 128 + (j & 127); }

__device__ __forceinline__ void p0_prologue(Frame& F, const Args& a) {
    const float* x = (const float*)a.in[0]; const float* mem = (const float*)a.in[1]; const int* positions = (const int*)a.in[2];
    const float* g_mix_pre = (const float*)a.in[3]; const float* w_in = (const float*)a.in[4];
    const float* a_log = (const float*)a.in[6]; const float* dt_bias = (const float*)a.in[7];
    const float* w_out = (const float*)a.in[10]; const float* g_cross_pre = (const float*)a.in[12]; const float* g_mem = (const float*)a.in[13];
    const float* w_cq = (const float*)a.in[14]; const float* w_ckv = (const float*)a.in[15]; const float* w_co = (const float*)a.in[16];
    const float* g_ffn_pre = (const float*)a.in[18]; const float* w_gu = (const float*)a.in[19]; const float* w_down = (const float*)a.in[20];
    bf16* R1 = (bf16*)(F.ws + WS_REG1);
    LAS float* W16s = (LAS float*)(F.lds);
    LAS float* scr = (LAS float*)(F.lds + 65536 + F.wave * 8448);
    const int gw = F.vcu * NWAVES + F.wave, NGW = F.G * NWAVES;
    for (int k = F.tid; k < D; k += NWAVES * 64) { const float gv = g_mix_pre[k]; const float* src = w_in + (size_t)k * INC + 2816;
#pragma unroll
        for (int c = 0; c < 16; ++c) W16s[c * D + k] = src[c] * gv; }
    constexpr int I_IN = 16 * 88, I_KV = 16 * 64, I_SQ = 16 * 32, I_GU = 16 * 176, I_DN = 44 * 32;
    constexpr int NITEMS = I_IN + I_KV + 3 * I_SQ + I_GU + I_DN;
    for (int it = gw; it < NITEMS; it += NGW) {
        int r = it;
        if (r < I_IN) { const int kb = r / 88, nb = r % 88; p0_transpose_item(w_in, INC, g_mix_pre, R1 + (size_t)R1_WIN * D, D, 64 * kb, 32 * nb, map_win(32 * nb), scr, F.lane); continue; } r -= I_IN;
        if (r < I_KV) { const int kb = r / 64, nb = r % 64; p0_transpose_item(w_ckv, 2048, g_mem, R1 + (size_t)R1_WK * D, D, 64 * kb, 32 * nb, 32 * nb, scr, F.lane); continue; } r -= I_KV;
        if (r < I_SQ) { const int kb = r / 32, nb = r % 32; p0_transpose_item(w_out, D, nullptr, (bf16*)(F.ws + WS_WOUT), D, 64 * kb, 32 * nb, 32 * nb, scr, F.lane); continue; } r -= I_SQ;
        if (r < I_SQ) { const int kb = r / 32, nb = r % 32; p0_transpose_item(w_cq, D, g_cross_pre, (bf16*)(F.ws + WS_WCQ), D, 64 * kb, 32 * nb, 32 * nb, scr, F.lane); continue; } r -= I_SQ;
        if (r < I_SQ) { const int kb = r / 32, nb = r % 32; p0_transpose_item(w_co, D, nullptr, (bf16*)(F.ws + WS_WCO), D, 64 * kb, 32 * nb, 32 * nb, scr, F.lane); continue; } r -= I_SQ;
        if (r < I_GU) { const int kb = r / 176, nb = r % 176; p0_transpose_item(w_gu, 2 * DFF, g_ffn_pre, (bf16*)(F.ws + WS_WGU), D, 64 * kb, 32 * nb, map_gu(32 * nb), scr, F.lane); continue; } r -= I_GU;
        { const int kb = r / 32, nb = r % 32; p0_transpose_item(w_down, D, nullptr, (bf16*)(F.ws + WS_WDOWN), DFF, 64 * kb, 32 * nb, 32 * nb, scr, F.lane); }
    }
    __syncthreads();
    float* gbuf = (float*)(F.ws + WS_GB);
    for (int m = gw; m < M; m += NGW) {
        const GAS f32x4* xr = (const GAS f32x4*)(x + (size_t)m * D) + F.lane;
        f32x4 v[4]; float s = 0.f;
#pragma unroll
        for (int j = 0; j < 4; ++j) { v[j] = xr[64 * j]; s += (v[j].x * v[j].x + v[j].y * v[j].y) + (v[j].z * v[j].z + v[j].w * v[j].w); }
        const float rstd = rsqrtf(wave_sum(s) * (1.f / D) + EPS);
#pragma unroll
        for (int j = 0; j < 4; ++j) v[j] = v[j] * rstd;
        GAS unsigned long long* o8 = (GAS unsigned long long*)(R1 + (size_t)(R1_XN + m) * D) + F.lane;
#pragma unroll
        for (int j = 0; j < 4; ++j) o8[64 * j] = (unsigned long long)pk2(v[j].x, v[j].y) | ((unsigned long long)pk2(v[j].z, v[j].w) << 32);
        float mine = 0.f;
#pragma unroll 2
        for (int c = 0; c < 16; ++c) { float p = 0.f;
#pragma unroll
            for (int j = 0; j < 4; ++j) { const f32x4 w = *(const LAS f32x4*)(W16s + c * D + 4 * F.lane + 256 * j); p += (v[j].x * w.x + v[j].y * w.y) + (v[j].z * w.z + v[j].w * w.w); }
            p = wave_sum(p); if (F.lane == c) mine = p; }
        if (F.lane < 16) { const int b = m >> 11, sidx = m & 2047;
            if (F.lane < 8) { const int dir = F.lane >> 2, h = F.lane & 3; const float av = mine + dt_bias[F.lane]; const float sp = av > 20.f ? av : log1pf(expf(av));
                gbuf[((size_t)(dir * 8 + b) * 4 + h) * 2048 + sidx] = -expf(a_log[F.lane]) * sp; }
            else { const int c = F.lane - 8, dir = c >> 2, h = c & 3; gbuf[131072 + ((size_t)(dir * 8 + b) * 4 + h) * 2048 + sidx] = 1.f / (1.f + expf(-mine)); } }
    }
    for (int m = gw; m < MMEM; m += NGW) {
        const GAS f32x4* xr = (const GAS f32x4*)(mem + (size_t)m * D) + F.lane;
        f32x4 v[4]; float s = 0.f;
#pragma unroll
        for (int j = 0; j < 4; ++j) { v[j] = xr[64 * j]; s += (v[j].x * v[j].x + v[j].y * v[j].y) + (v[j].z * v[j].z + v[j].w * v[j].w); }
        const float rstd = rsqrtf(wave_sum(s) * (1.f / D) + EPS);
        GAS unsigned long long* o8 = (GAS unsigned long long*)(R1 + (size_t)(R1_MEMN + m) * D) + F.lane;
#pragma unroll
        for (int j = 0; j < 4; ++j) o8[64 * j] = (unsigned long long)pk2(v[j].x * rstd, v[j].y * rstd) | ((unsigned long long)pk2(v[j].z * rstd, v[j].w * rstd) << 32);
    }
    { float2* rope = (float2*)(F.ws + WS_ROPE); const int gt = F.vcu * (NWAVES * 64) + F.tid, NT = F.G * NWAVES * 64;
      for (int e = gt; e < M * 32; e += NT) { const int tok = e >> 5, d = e & 31; const float pos = (float)positions[tok];
          const float inv = powf(10000.f, -(float)d / 32.f); const float ang = pos * inv;
          const double ar = (double)ang * 0.15915494309189535; const double fr = ar - rint(ar);
          rope[e] = make_float2(__builtin_amdgcn_cosf((float)fr), __builtin_amdgcn_sinf((float)fr)); } }
}

struct SchedP1 {
    int G, c;
    __device__ bool next(int i, pg8::Unit& u) const {
        const int L = i * G + c; if (L >= 768) return false;
        if (L < 704) { const int nwg = 704, nN = 11, nM = 64; int wgid = L; { const int q = nwg / 8, xcd = wgid % 8, off = wgid / 8; wgid = xcd * q + off; }
            const int nig = 8 * nN, gid = wgid / nig, fm = gid * 8; u.pm = fm + ((wgid % nig) % 8); u.pn = T_WIN + (wgid % nig) / 8; (void)nM; return true; }
        const int idx = L - 704;
        if (idx < 32) { u.pm = T_MEMN + (idx >> 2); u.pn = T_WK + (idx & 3); } else { const int j = idx - 32; u.pm = T_WV + (j >> 3); u.pn = T_MEMN + (j & 7); }
        return true;
    }
    __device__ __forceinline__ void a_ready(const pg8::Unit&) const {}
    __device__ __forceinline__ void done(const pg8::Unit&) const {}
};
typedef pg8::f32x4 (AccT)[2][2][4][2];
__device__ __forceinline__ void store_tile(const pg8::f32x4 (&acc)[2][2][4][2], bf16* base, int ldc, int row0, int col0, float sc) {
#pragma unroll
    for (int ai = 0; ai < 2; ++ai)
#pragma unroll
        for (int m = 0; m < 4; ++m) { bf16* rowp = base + (size_t)(row0 + ai * 128 + m * 16) * ldc + col0;
#pragma unroll
            for (int bj = 0; bj < 2; ++bj) { const pg8::f32x4 v0 = acc[ai][bj][m][0] * sc, v1 = acc[ai][bj][m][1] * sc; pg8::u32x4 w;
                w.x = pg8::cvt_pk_bf16(v0[0], v0[1]); w.y = pg8::cvt_pk_bf16(v0[2], v0[3]); w.z = pg8::cvt_pk_bf16(v1[0], v1[1]); w.w = pg8::cvt_pk_bf16(v1[2], v1[3]);
                *(pg8::u32x4*)(rowp + bj * 128) = w; } }
}
__device__ __forceinline__ void store_rope(const pg8::f32x4 (&acc)[2][2][4][2], bf16* base, int ldc, int row0, int c1, int fq, const float2* rope, float sc) {
#pragma unroll
    for (int ai = 0; ai < 2; ++ai)
#pragma unroll
        for (int m = 0; m < 4; ++m) { const int row = row0 + ai * 128 + m * 16; const float4* rp = (const float4*)(rope + (size_t)row * 32 + 8 * fq);
            const float4 r0 = rp[0], r1 = rp[1], r2 = rp[2], r3 = rp[3];
            const float cs[8] = {r0.x, r0.z, r1.x, r1.z, r2.x, r2.z, r3.x, r3.z}, sn[8] = {r0.y, r0.w, r1.y, r1.w, r2.y, r2.w, r3.y, r3.w};
            float y1[8], y2[8];
#pragma unroll
            for (int n = 0; n < 2; ++n)
#pragma unroll
                for (int e = 0; e < 4; ++e) { const float x1 = acc[ai][0][m][n][e], x2 = acc[ai][1][m][n][e]; const int d = 4 * n + e;
                    y1[d] = (x1 * cs[d] - x2 * sn[d]) * sc; y2[d] = (x2 * cs[d] + x1 * sn[d]) * sc; }
            bf16* rowp = base + (size_t)row * ldc + c1 + 8 * fq; pg8::u32x4 w;
            w.x = pg8::cvt_pk_bf16(y1[0], y1[1]); w.y = pg8::cvt_pk_bf16(y1[2], y1[3]); w.z = pg8::cvt_pk_bf16(y1[4], y1[5]); w.w = pg8::cvt_pk_bf16(y1[6], y1[7]); *(pg8::u32x4*)(rowp) = w;
            w.x = pg8::cvt_pk_bf16(y2[0], y2[1]); w.y = pg8::cvt_pk_bf16(y2[2], y2[3]); w.z = pg8::cvt_pk_bf16(y2[4], y2[5]); w.w = pg8::cvt_pk_bf16(y2[6], y2[7]); *(pg8::u32x4*)(rowp + 32) = w; }
}
struct EpiP1 {
    static constexpr bool PERM = true, AFTER_DRAIN = false;
    unsigned char* ws;
    __device__ __forceinline__ void operator()(const pg8::f32x4 (&acc)[2][2][4][2], const pg8::Unit& u, int wr, int wc, int fr, int fq) const {
        const int rloc = wr * 64 + fr, cloc = wc * 32 + 8 * fq;
        if (u.pm >= T_WV) { store_tile(acc, (bf16*)(ws + WS_VCT), 2048, (u.pm - T_WV) * 256 + rloc, (u.pn - T_MEMN) * 256 + cloc, 1.f); return; }
        if (u.pm >= T_MEMN) { store_tile(acc, (bf16*)(ws + WS_KC), 1024, (u.pm - T_MEMN) * 256 + rloc, (u.pn - T_WK) * 256 + cloc, 1.f); return; }
        const int pl = u.pn - T_WIN, row0 = u.pm * 256 + rloc;
        if (pl >= 9) { store_tile(acc, (bf16*)(ws + WS_DGATE), 512, row0, (pl - 9) * 256 + cloc, 1.f); return; }
        if (pl >= 3) { store_tile(acc, (bf16*)(ws + WS_DQKV), 1536, row0, (pl - 3) * 256 + cloc, 1.f); return; }
        const float2* rope = (const float2*)(ws + WS_ROPE);
        if (pl < 2) { store_rope(acc, (bf16*)(ws + WS_QA), 512, row0, (pl * 4 + wc) * 64, fq, rope, QSCALE_A); return; }
        if (wc < 2) { store_rope(acc, (bf16*)(ws + WS_KA), 128, row0, wc * 64, fq, rope, 1.f); return; }
        bf16* base = (bf16*)(ws + WS_VA);
#pragma unroll
        for (int ai = 0; ai < 2; ++ai)
#pragma unroll
            for (int m = 0; m < 4; ++m) { bf16* rowp = base + (size_t)(row0 + ai * 128 + m * 16) * 128 + (wc - 2) * 32 + 8 * fq;
#pragma unroll
                for (int bj = 0; bj < 2; ++bj) { const pg8::f32x4 v0 = acc[ai][bj][m][0], v1 = acc[ai][bj][m][1]; pg8::u32x4 w;
                    w.x = pg8::cvt_pk_bf16(v0[0], v0[1]); w.y = pg8::cvt_pk_bf16(v0[2], v0[3]); w.z = pg8::cvt_pk_bf16(v1[0], v1[1]); w.w = pg8::cvt_pk_bf16(v1[2], v1[3]);
                    *(pg8::u32x4*)(rowp + bj * 64) = w; } }
    }
};
struct EpiPlain {
    static constexpr bool PERM = true, AFTER_DRAIN = false;
    bf16* O; int ldc; float scale;
    __device__ __forceinline__ void operator()(const pg8::f32x4 (&acc)[2][2][4][2], const pg8::Unit& u, int wr, int wc, int fr, int fq) const {
        store_tile(acc, O, ldc, u.pm * 256 + wr * 64 + fr, u.pn * 256 + wc * 32 + 8 * fq, scale);
    }
};
struct EpiSwiglu {
    static constexpr bool PERM = true, AFTER_DRAIN = false;
    bf16* O;
    __device__ __forceinline__ void operator()(const pg8::f32x4 (&acc)[2][2][4][2], const pg8::Unit& u, int wr, int wc, int fr, int fq) const {
        const int row0 = u.pm * 256 + wr * 64 + fr, col0 = u.pn * 128 + wc * 32 + 8 * fq;
#pragma unroll
        for (int ai = 0; ai < 2; ++ai)
#pragma unroll
            for (int m = 0; m < 4; ++m) { float y[8];
#pragma unroll
                for (int n = 0; n < 2; ++n)
#pragma unroll
                    for (int e = 0; e < 4; ++e) { const float gt = acc[ai][0][m][n][e], up = acc[ai][1][m][n][e]; y[4 * n + e] = gt * __builtin_amdgcn_rcpf(1.f + __builtin_amdgcn_exp2f(-LOG2E * gt)) * up; }
                pg8::u32x4 w; w.x = pg8::cvt_pk_bf16(y[0], y[1]); w.y = pg8::cvt_pk_bf16(y[2], y[3]); w.z = pg8::cvt_pk_bf16(y[4], y[5]); w.w = pg8::cvt_pk_bf16(y[6], y[7]);
                *(pg8::u32x4*)(O + (size_t)(row0 + ai * 128 + m * 16) * DFF + col0) = w; }
    }
};
__device__ __forceinline__ void row_pass(Frame& F, const float* base, const bf16* y, const float* g, float* xout, bf16* xn) {
    const int gw = F.vcu * NWAVES + F.wave, NGW = F.G * NWAVES;
    f32x4 gg[4];
#pragma unroll
    for (int j = 0; j < 4; ++j) gg[j] = ((const GAS f32x4*)g)[F.lane + 64 * j];
    for (int m = gw; m < M; m += NGW) {
        const GAS v2u* yr = (const GAS v2u*)(y + (size_t)m * D) + F.lane; const GAS f32x4* br = (const GAS f32x4*)(base + (size_t)m * D) + F.lane;
        f32x4 yv[4], bv[4]; float s = 0.f;
#pragma unroll
        for (int j = 0; j < 4; ++j) { const v2u w = yr[64 * j]; bv[j] = br[64 * j]; yv[j] = (f32x4){bflo(w.x), bfhi(w.x), bflo(w.y), bfhi(w.y)};
            s += (yv[j].x * yv[j].x + yv[j].y * yv[j].y) + (yv[j].z * yv[j].z + yv[j].w * yv[j].w); }
        const float r = rsqrtf(wave_sum(s) * (1.f / D) + EPS); float s2 = 0.f;
        GAS f32x4* orow = (GAS f32x4*)(xout + (size_t)m * D) + F.lane;
#pragma unroll
        for (int j = 0; j < 4; ++j) { bv[j] = bv[j] + yv[j] * r * gg[j]; orow[64 * j] = bv[j]; s2 += (bv[j].x * bv[j].x + bv[j].y * bv[j].y) + (bv[j].z * bv[j].z + bv[j].w * bv[j].w); }
        if (xn) { const float r2 = rsqrtf(wave_sum(s2) * (1.f / D) + EPS); GAS unsigned long long* o8 = (GAS unsigned long long*)(xn + (size_t)m * D) + F.lane;
#pragma unroll
            for (int j = 0; j < 4; ++j) o8[64 * j] = (unsigned long long)pk2(bv[j].x * r2, bv[j].y * r2) | ((unsigned long long)pk2(bv[j].z * r2, bv[j].w * r2) << 32); }
    }
}
__device__ __forceinline__ void dn_combine(Frame& F, const float* g_out) {
    const int gw = F.vcu * NWAVES + F.wave, NGW = F.G * NWAVES;
    const bf16* ofb = (const bf16*)(F.ws + WS_OFB); const bf16* gate = (const bf16*)(F.ws + WS_DGATE); bf16* mix = (bf16*)(F.ws + WS_MIX);
    float go[8];
#pragma unroll
    for (int e = 0; e < 8; ++e) go[e] = g_out[((8 * F.lane) & 127) + e];
    for (int m = gw; m < M; m += NGW) {
        const v4u a = *(const GAS v4u*)(ofb + (size_t)m * 512 + 8 * F.lane), b = *(const GAS v4u*)(ofb + ((size_t)M + m) * 512 + 8 * F.lane), gt = *(const GAS v4u*)(gate + (size_t)m * 512 + 8 * F.lane);
        float o[8], gv[8];
        o[0] = bflo(a.x) + bflo(b.x); o[1] = bfhi(a.x) + bfhi(b.x); o[2] = bflo(a.y) + bflo(b.y); o[3] = bfhi(a.y) + bfhi(b.y);
        o[4] = bflo(a.z) + bflo(b.z); o[5] = bfhi(a.z) + bfhi(b.z); o[6] = bflo(a.w) + bflo(b.w); o[7] = bfhi(a.w) + bfhi(b.w);
        gv[0] = bflo(gt.x); gv[1] = bfhi(gt.x); gv[2] = bflo(gt.y); gv[3] = bfhi(gt.y); gv[4] = bflo(gt.z); gv[5] = bfhi(gt.z); gv[6] = bflo(gt.w); gv[7] = bfhi(gt.w);
        float s = 0.f;
#pragma unroll
        for (int e = 0; e < 8; ++e) s += o[e] * o[e];
        s += __shfl_xor(s, 1); s += __shfl_xor(s, 2); s += __shfl_xor(s, 4); s += __shfl_xor(s, 8);
        const float r = rsqrtf(s * (1.f / 128.f) + EPS);
#pragma unroll
        for (int e = 0; e < 8; ++e) o[e] = o[e] * r * go[e] * silu_f(gv[e]);
        v4u w; w.x = pk2(o[0], o[1]); w.y = pk2(o[2], o[3]); w.z = pk2(o[4], o[5]); w.w = pk2(o[6], o[7]);
        *(GAS v4u*)(mix + (size_t)m * D + 512 + 8 * F.lane) = w;
    }
}
typedef float f32x16 __attribute__((ext_vector_type(16)));
typedef float f32x2_t __attribute__((ext_vector_type(2)));
typedef __bf16 bf16x2_t __attribute__((ext_vector_type(2)));
__device__ __forceinline__ unsigned cvtpk(float lo, float hi) { f32x2_t v = {lo, hi}; bf16x2_t b = __builtin_convertvector(v, bf16x2_t); return __builtin_bit_cast(unsigned, b); }
__device__ __forceinline__ int crow(int r, int hi) { return (r & 3) + 8 * (r >> 2) + 4 * hi; }
#define MFMA32(a, b, c) __builtin_amdgcn_mfma_f32_32x32x16_bf16((a), (b), (c), 0, 0, 0)
__device__ __forceinline__ bf16x8 pack8(const f32x16& x, int s) {
    v4u p; p.x = cvtpk(x[8 * s], x[8 * s + 1]); p.y = cvtpk(x[8 * s + 2], x[8 * s + 3]); p.z = cvtpk(x[8 * s + 4], x[8 * s + 5]); p.w = cvtpk(x[8 * s + 6], x[8 * s + 7]);
    return __builtin_bit_cast(bf16x8, p);
}
__device__ __forceinline__ float max16(const f32x16& x) {
    float a = fmaxf(fmaxf(x[0], x[1]), fmaxf(x[2], x[3])), b = fmaxf(fmaxf(x[4], x[5]), fmaxf(x[6], x[7]));
    float c = fmaxf(fmaxf(x[8], x[9]), fmaxf(x[10], x[11])), d = fmaxf(fmaxf(x[12], x[13]), fmaxf(x[14], x[15]));
    return fmaxf(fmaxf(a, b), fmaxf(c, d));
}
__device__ __forceinline__ int perm16(int k) { return 8 * ((k >> 2) & 1) + ((k >> 3) << 2) + (k & 3); }

__device__ __forceinline__ void cross_attn_phase(Frame& F) {
    const bf16* QC = (const bf16*)(F.ws + WS_QC); const bf16* KC = (const bf16*)(F.ws + WS_KC); const bf16* VCT = (const bf16*)(F.ws + WS_VCT); bf16* OC = (bf16*)(F.ws + WS_OC);
    LAS unsigned char* L = F.lds;
    LAS float* lsc = (LAS float*)(F.lds + 131072) + F.wave * 32;
    const int lane = F.lane, r32 = lane & 31, hi = lane >> 5, sw = r32 & 15;
    for (int u = F.vcu; u < 256; u += F.G) {
        const int bh = u >> 3, qb = u & 7, b = bh >> 2, hd = bh & 3;
        __syncthreads();
#pragma unroll 4
        for (int i = 0; i < 16; ++i) { const int it = F.tid + 512 * i, key = it >> 5, c = it & 31;
            const v4u v = *(const GAS v4u*)(KC + (size_t)(b * 256 + key) * 1024 + hd * 256 + 8 * c);
            *(LAS v4u*)(L + key * 512 + ((c ^ (key & 15)) << 4)) = v; }
        __syncthreads();
        const size_t tok0 = (size_t)b * 2048 + qb * 256 + F.wave * 32;
        const bf16* qrow = QC + (tok0 + r32) * 1024 + hd * 256 + 8 * hi;
        f32x16 acc[8];
#pragma unroll
        for (int kt = 0; kt < 8; ++kt)
#pragma unroll
            for (int r = 0; r < 16; ++r) acc[kt][r] = 0.f;
#pragma unroll 2
        for (int ks = 0; ks < 16; ++ks) {
            const bf16x8 qf = *(const GAS bf16x8*)(qrow + 16 * ks);
            const int coff = ((2 * ks + hi) ^ sw) << 4;
#pragma unroll
            for (int kt = 0; kt < 8; ++kt) { const bf16x8 kf = *(const LAS bf16x8*)(L + (32 * kt + r32) * 512 + coff); acc[kt] = MFMA32(kf, qf, acc[kt]); }
        }
        float m = max16(acc[0]);
#pragma unroll
        for (int kt = 1; kt < 8; ++kt) m = fmaxf(m, max16(acc[kt]));
        m = fmaxf(m, __shfl_xor(m, 32));
        float l = 0.f;
#pragma unroll
        for (int kt = 0; kt < 8; ++kt)
#pragma unroll
            for (int r = 0; r < 16; ++r) { const float p = __builtin_amdgcn_exp2f(acc[kt][r] - m); acc[kt][r] = p; l += p; }
        l += __shfl_xor(l, 32);
        bf16x8 pa[8][2];
#pragma unroll
        for (int kt = 0; kt < 8; ++kt) { pa[kt][0] = pack8(acc[kt], 0); pa[kt][1] = pack8(acc[kt], 1); }
        if (hi == 0) lsc[r32] = l;
        __syncthreads();
#pragma unroll 4
        for (int i = 0; i < 8; ++i) { const int it = F.tid + 512 * i, d = it >> 4, g = it & 15;
            const bf16* src = VCT + (size_t)(hd * 256 + d) * 2048 + b * 256 + 16 * g;
            const v4u A = *(const GAS v4u*)(src), B = *(const GAS v4u*)(src + 8);
            *(LAS v4u*)(L + d * 512 + (((2 * g) ^ (d & 15)) << 4)) = (v4u){A.x, A.y, B.x, B.y};
            *(LAS v4u*)(L + d * 512 + (((2 * g + 1) ^ (d & 15)) << 4)) = (v4u){A.z, A.w, B.z, B.w}; }
        __syncthreads();
        float rl[16];
#pragma unroll
        for (int r = 0; r < 16; ++r) rl[r] = __builtin_amdgcn_rcpf(lsc[crow(r, hi)]);
#pragma unroll 1
        for (int dt = 0; dt < 8; ++dt) {
            f32x16 o;
#pragma unroll
            for (int r = 0; r < 16; ++r) o[r] = 0.f;
            const LAS unsigned char* vrow = L + (32 * dt + r32) * 512;
#pragma unroll
            for (int kt = 0; kt < 8; ++kt)
#pragma unroll
                for (int s = 0; s < 2; ++s) { const bf16x8 vf = *(const LAS bf16x8*)(vrow + (((4 * kt + 2 * s + hi) ^ sw) << 4)); o = MFMA32(pa[kt][s], vf, o); }
            bf16* op = OC + tok0 * 1024 + hd * 256 + 32 * dt + r32;
#pragma unroll
            for (int r = 0; r < 16; ++r) op[(size_t)crow(r, hi) * 1024] = (bf16)f2bf(o[r] * rl[r]);
        }
    }
}

__device__ __forceinline__ void window_attn_phase(Frame& F, const float* sink) {
    const bf16* QA = (const bf16*)(F.ws + WS_QA); const bf16* KA = (const bf16*)(F.ws + WS_KA); const bf16* VA = (const bf16*)(F.ws + WS_VA); bf16* MIX = (bf16*)(F.ws + WS_MIX);
    LAS unsigned char* LK = F.lds;
    LAS unsigned char* LV = F.lds + 49152;
    LAS float* lsc = (LAS float*)(F.lds + 98304) + F.wave * 32;
    const int lane = F.lane, r32 = lane & 31, hi = lane >> 5;
    for (int u = F.vcu; u < 256; u += F.G) {
        const int b = u >> 5, kvh = (u >> 4) & 1, n = u & 15;
        const int tokb = b * 2048 + 128 * (n - 1);
        __syncthreads();
#pragma unroll 2
        for (int i = 0; i < 6; ++i) { const int it = F.tid + 512 * i, key = it >> 3, c = it & 7; const int t = 128 * (n - 1) + key;
            v4u kv = (v4u){0u, 0u, 0u, 0u}, vv = kv;
            if (t >= 0 && t < 2048) { kv = *(const GAS v4u*)(KA + (size_t)(tokb + key) * 128 + kvh * 64 + 8 * c); vv = *(const GAS v4u*)(VA + (size_t)(tokb + key) * 128 + kvh * 64 + 8 * c); }
            *(LAS v4u*)(LK + key * 128 + ((c ^ ((key >> 1) & 7)) << 4)) = kv;
            const int pos = (key & ~15) | perm16(key & 15);
            const unsigned w[4] = {vv.x, vv.y, vv.z, vv.w};
#pragma unroll
            for (int e = 0; e < 8; ++e) { const int d = 8 * c + e; const unsigned short val = (e & 1) ? (unsigned short)(w[e >> 1] >> 16) : (unsigned short)(w[e >> 1] & 0xffffu);
                *(LAS unsigned short*)(LV + d * 768 + (((pos >> 3) ^ (d & 15)) << 4) + (pos & 7) * 2) = val; } }
        __syncthreads();
        const int g = F.wave >> 1, th = F.wave & 1, hq = kvh * 4 + g;
        const float sinkl = sink[hq] * LOG2E;
#pragma unroll 1
        for (int qt = 0; qt < 2; ++qt) {
            const int q0 = 64 * th + 32 * qt, qq = q0 + r32;
            const size_t tokq = (size_t)b * 2048 + 128 * n + q0;
            bf16x8 qf[4];
#pragma unroll
            for (int ks = 0; ks < 4; ++ks) qf[ks] = *(const GAS bf16x8*)(QA + (tokq + r32) * 512 + hq * 64 + 16 * ks + 8 * hi);
            const int kt_lo = q0 >> 5, kt_hi = (287 + q0) >> 5;
            const int klo = (n == 0) ? 128 : 0, khi = (n == 15) ? 255 : 383;
            float m = -INFINITY;
#pragma unroll 1
            for (int kt = kt_lo; kt <= kt_hi; ++kt) {
                f32x16 s;
#pragma unroll
                for (int r = 0; r < 16; ++r) s[r] = 0.f;
                const int key = 32 * kt + r32;
#pragma unroll
                for (int ks = 0; ks < 4; ++ks) { const bf16x8 kf = *(const LAS bf16x8*)(LK + key * 128 + (((2 * ks + hi) ^ ((key >> 1) & 7)) << 4)); s = MFMA32(kf, qf[ks], s); }
#pragma unroll
                for (int r = 0; r < 16; ++r) { const int kk = 32 * kt + crow(r, hi); const bool ok = (kk >= qq) && (kk <= 256 + qq) && (kk >= klo) && (kk <= khi); m = fmaxf(m, ok ? s[r] : -INFINITY); }
            }
            m = fmaxf(m, __shfl_xor(m, 32)); m = fmaxf(m, sinkl);
            float l = 0.f; f32x16 o0, o1;
#pragma unroll
            for (int r = 0; r < 16; ++r) { o0[r] = 0.f; o1[r] = 0.f; }
#pragma unroll 1
            for (int kt = kt_lo; kt <= kt_hi; ++kt) {
                f32x16 s;
#pragma unroll
                for (int r = 0; r < 16; ++r) s[r] = 0.f;
                const int key = 32 * kt + r32;
#pragma unroll
                for (int ks = 0; ks < 4; ++ks) { const bf16x8 kf = *(const LAS bf16x8*)(LK + key * 128 + (((2 * ks + hi) ^ ((key >> 1) & 7)) << 4)); s = MFMA32(kf, qf[ks], s); }
#pragma unroll
                for (int r = 0; r < 16; ++r) { const int kk = 32 * kt + crow(r, hi); const bool ok = (kk >= qq) && (kk <= 256 + qq) && (kk >= klo) && (kk <= khi);
                    const float p = ok ? __builtin_amdgcn_exp2f(s[r] - m) : 0.f; s[r] = p; l += p; }
#pragma unroll
                for (int ss = 0; ss < 2; ++ss) { const bf16x8 pa = pack8(s, ss); const int ch = 4 * kt + 2 * ss + hi;
                    const bf16x8 v0 = *(const LAS bf16x8*)(LV + r32 * 768 + ((ch ^ (r32 & 15)) << 4)), v1 = *(const LAS bf16x8*)(LV + (32 + r32) * 768 + ((ch ^ (r32 & 15)) << 4));
                    o0 = MFMA32(pa, v0, o0); o1 = MFMA32(pa, v1, o1); }
            }
            l += __shfl_xor(l, 32); l += __builtin_amdgcn_exp2f(sinkl - m);
            if (hi == 0) lsc[r32] = l;
            bf16* op = MIX + tokq * 1024 + hq * 64 + r32;
#pragma unroll
            for (int r = 0; r < 16; ++r) { const float rl = __builtin_amdgcn_rcpf(lsc[crow(r, hi)]); op[(size_t)crow(r, hi) * 1024] = (bf16)f2bf(o0[r] * rl); op[(size_t)crow(r, hi) * 1024 + 32] = (bf16)f2bf(o1[r] * rl); }
        }
    }
}
constexpr size_t PS_BYTES = 32768, PD_BYTES = 40960; constexpr int SC_FLOATS = 192;
constexpr size_t WS_PD = 157 * MiB;
constexpr size_t OUT_PS = 0, OUT_SC = 32 * MiB;
__device__ __forceinline__ int krow(int s, int h, int j) { return 16 * s + 8 * (j >> 2) + 4 * h + (j & 3); }
#define BAR_LDS() asm volatile("s_waitcnt lgkmcnt(0)\n\ts_barrier" ::: "memory")

constexpr int DL_QS = 0, DL_KS = 16384, DL_KT = 32768, DL_VT = 49152, DL_LM = 65536, DL_TI = 98304, DL_SM = 131072;
__device__ __forceinline__ int img256(int row, int chunk) { return row * 256 + ((chunk ^ (row & 15)) << 4); }
__device__ __forceinline__ int img128(int row, int chunk) { return row * 128 + ((chunk ^ ((row >> 1) & 7)) << 4); }

__device__ __forceinline__ void dn_prep_phase(Frame& F, const float* conv_w) {
    const bf16* DQ = (const bf16*)(F.ws + WS_DQKV); const float* gb = (const float*)(F.ws + WS_GB);
    LAS unsigned char* L = F.lds;
    LAS float* RQ = (LAS float*)(L + DL_SM); LAS float* RK = RQ + 64; LAS float* BETA = RQ + 128; LAS float* GCN = RQ + 256; LAS float* GLs = RQ + 384;
    LAS float* PART = (LAS float*)(L + DL_LM);
    const int tid0 = F.tid, lane0 = F.lane, wave = F.wave;
    for (int u = F.vcu; u < 1024; u += F.G) {
        int tid = tid0, lane = lane0; asm volatile("" : "+v"(tid), "+v"(lane));
        const int r32 = lane & 31, hi = lane >> 5;
        const int c = u & 31, h = (u >> 5) & 3, b = u >> 7, bhc = u;
        const size_t tok0 = (size_t)b * 2048 + 64 * c;
        unsigned char* PS = (unsigned char*)F.out + OUT_PS + (size_t)bhc * PS_BYTES;
        __syncthreads();
#pragma unroll 1
        for (int i = 0; i < 6; ++i) { const int it = tid + 512 * i, cg = it % 48, t = it / 48; const int kind = cg >> 4, c8 = (cg & 15) * 8;
            const int col = kind * 512 + h * 128 + c8; float acc[8];
#pragma unroll
            for (int e = 0; e < 8; ++e) acc[e] = 0.f;
#pragma unroll
            for (int w = 0; w < 5; ++w) { const int tt = 64 * c + t + w - 2;
                if (tt >= 0 && tt < 2048) { const v4u x = *(const GAS v4u*)(DQ + ((size_t)b * 2048 + tt) * 1536 + col);
                    const f32x4 w0 = *(const GAS f32x4*)(conv_w + w * 1536 + col), w1 = *(const GAS f32x4*)(conv_w + w * 1536 + col + 4);
                    acc[0] += bflo(x.x) * w0.x; acc[1] += bfhi(x.x) * w0.y; acc[2] += bflo(x.y) * w0.z; acc[3] += bfhi(x.y) * w0.w;
                    acc[4] += bflo(x.z) * w1.x; acc[5] += bfhi(x.z) * w1.y; acc[6] += bflo(x.w) * w1.z; acc[7] += bfhi(x.w) * w1.w; } }
            float ss = 0.f;
#pragma unroll
            for (int e = 0; e < 8; ++e) { acc[e] = acc[e] / (1.f + __expf(-acc[e])); ss += acc[e] * acc[e]; }
            v4u pk; pk.x = pk2(acc[0], acc[1]); pk.y = pk2(acc[2], acc[3]); pk.z = pk2(acc[4], acc[5]); pk.w = pk2(acc[6], acc[7]);
            if (kind < 2) { PART[t * 32 + cg] = ss; *(LAS v4u*)(L + (kind ? DL_KS : DL_QS) + img256(t, cg & 15)) = pk; }
            if (kind >= 1) { LAS unsigned char* T = L + (kind == 1 ? DL_KT : DL_VT); const unsigned wds[4] = {pk.x, pk.y, pk.z, pk.w};
#pragma unroll
                for (int e = 0; e < 8; ++e) { const int ch = c8 + e; const unsigned short val = (e & 1) ? (unsigned short)(wds[e >> 1] >> 16) : (unsigned short)(wds[e >> 1] & 0xffffu);
                    *(LAS unsigned short*)(T + img128(ch, t >> 3) + (t & 7) * 2) = val; } } }
        __syncthreads();
        if (tid < 128) { const int t = tid & 63, which = tid >> 6; float s = 0.f;
#pragma unroll
            for (int k = 0; k < 16; ++k) s += PART[t * 32 + which * 16 + k];
            if (which == 0) RQ[t] = rsqrtf(s + EPS) * 0.08838834764831845f; else RK[t] = rsqrtf(s + EPS); }
        else if (tid < 256) { const int d = (tid - 128) >> 6, t = tid & 63; const size_t o = ((size_t)(d * 8 + b) * 4 + h) * 2048 + 64 * c + t;
            float g = gb[o]; BETA[d * 64 + t] = gb[131072 + o];
            if (d == 0) { for (int k = 1; k < 64; k <<= 1) { const float v = __shfl_up(g, k); if (t >= k) g += v; } }
            else { for (int k = 1; k < 64; k <<= 1) { const float v = __shfl_down(g, k); if (t + k < 64) g += v; } }
            GCN[d * 64 + t] = g; if ((d == 0 && t == 63) || (d == 1 && t == 0)) GLs[d] = g; }
        __syncthreads();
        { const int at = (wave >> 1) & 1, bt = wave & 1; f32x16 acc;
#pragma unroll
          for (int r = 0; r < 16; ++r) acc[r] = 0.f;
          const int rowA = 32 * at + r32, rowB = 32 * bt + r32; const int offB = (wave < 4) ? DL_KS : DL_QS;
#pragma unroll
          for (int ks = 0; ks < 8; ++ks) { const bf16x8 af = *(const LAS bf16x8*)(L + DL_KS + img256(rowA, 2 * ks + hi)), bf = *(const LAS bf16x8*)(L + offB + img256(rowB, 2 * ks + hi)); acc = MFMA32(af, bf, acc); }
          const int cc = 32 * bt + r32;
          if (wave < 4) {
#pragma unroll
              for (int d = 0; d < 2; ++d) { const float rkc = RK[cc], gcc = GCN[d * 64 + cc]; LAS float* LM = (LAS float*)(L + DL_LM + d * 16384);
#pragma unroll
                  for (int r = 0; r < 16; ++r) { const int a = 32 * at + crow(r, hi); const bool ok = d ? (cc > a) : (cc < a);
                      const float ga = GCN[d * 64 + a], ba = BETA[d * 64 + a], rka = RK[a];
                      const float e = __expf(fminf(ga - gcc, 0.f)); float v = ba * rka * rkc * acc[r] * e; v = ok ? v : 0.f;
                      LM[(d ? 63 - a : a) * 64 + (d ? 63 - cc : cc)] = v; } }
          } else {
#pragma unroll
              for (int d = 0; d < 2; ++d) { const float rqt = RQ[cc], gct = GCN[d * 64 + cc]; unsigned char* QKL = F.ws + WS_PD + (size_t)(bhc * 2 + d) * PD_BYTES + 32768;
#pragma unroll
                  for (int g = 0; g < 4; ++g) { float v[4];
#pragma unroll
                      for (int e = 0; e < 4; ++e) { const int s = 32 * at + 8 * g + 4 * hi + e; const bool ok = d ? (s >= cc) : (s <= cc);
                          const float gs = GCN[d * 64 + s], rks = RK[s];
                          const float ex = __expf(fminf(gct - gs, 0.f)); const float vv = rqt * rks * acc[4 * g + e] * ex; v[e] = ok ? vv : 0.f; }
                      const int ksq = 2 * at + (g >> 1), lanep = r32 + 32 * (g & 1);
                      v2u w; w.x = pk2(v[0], v[1]); w.y = pk2(v[2], v[3]);
                      *(GAS v2u*)(QKL + ((size_t)((bt * 4 + ksq) * 64 + lanep)) * 16 + 8 * hi) = w; } }
          } }
        __syncthreads();
        if (wave < 2) {
            const int d = wave; const LAS float* LM = (const LAS float*)(L + DL_LM + d * 16384);
            float x[64];
#pragma unroll
            for (int i = 0; i < 64; ++i) x[i] = 0.f;
#pragma unroll
            for (int i = 0; i < 64; ++i) { float a0 = (lane == i) ? 1.f : 0.f, a1 = 0.f;
#pragma unroll
                for (int j4 = 0; j4 < (i + 3) / 4; ++j4) { const f32x4 l4 = *(const LAS f32x4*)(LM + i * 64 + 4 * j4);
                    a0 = fmaf(-l4.x, x[4 * j4], a0); a1 = fmaf(-l4.y, x[4 * j4 + 1], a1); a0 = fmaf(-l4.z, x[4 * j4 + 2], a0); a1 = fmaf(-l4.w, x[4 * j4 + 3], a1); }
                x[i] = a0 + a1; __builtin_amdgcn_sched_barrier(0); }
            const int s = d ? 63 - lane : lane; const float cu = BETA[d * 64 + s], cw = cu * RK[s] * __expf(GCN[d * 64 + s]);
            LAS unsigned char* TIU = L + DL_TI + d * 16384; LAS unsigned char* TIW = TIU + 8192;
            const int sc = s >> 3, sb = (s & 7) * 2;
            int baseK[8];
#pragma unroll
            for (int K = 0; K < 8; ++K) baseK[K] = DL_TI + d * 16384 + ((sc ^ K) << 4) + sb;
#define TI_WRITE(T_OF_I) _Pragma("unroll") for (int i = 0; i < 64; ++i) { const int t = (T_OF_I); const unsigned w2 = cvtpk(x[i] * cu, x[i] * cw); \
                LAS unsigned char* p = L + baseK[(t >> 1) & 7] + t * 128; *(LAS unsigned short*)(p) = (unsigned short)(w2 & 0xffffu); *(LAS unsigned short*)(p + 8192) = (unsigned short)(w2 >> 16); \
                if ((i & 3) == 3) __builtin_amdgcn_sched_barrier(0); }
            if (d == 0) { TI_WRITE(i) } else { TI_WRITE(63 - i) }
#undef TI_WRITE
        } else {
            const int x = tid - 128;
            for (int it = x; it < 1024; it += 384) { const int lp = it & 63, s = (it >> 6) & 1, rt = (it >> 7) & 1, w = it >> 8; const int t = 32 * rt + (lp & 31), hp = lp >> 5;
                const v2u lo = *(const LAS v2u*)(L + DL_QS + img256(t, 4 * w + 2 * s) + 8 * hp), hi2 = *(const LAS v2u*)(L + DL_QS + img256(t, 4 * w + 2 * s + 1) + 8 * hp);
                *(GAS v4u*)(PS + (size_t)it * 16) = (v4u){lo.x, lo.y, hi2.x, hi2.y}; }
            for (int it = x; it < 1024; it += 384) { const int lp = it & 63, ks = (it >> 6) & 3, w = it >> 8; const int dk = 32 * w + (lp & 31), hp = lp >> 5;
                *(GAS v4u*)(PS + 16384 + (size_t)it * 16) = *(const LAS v4u*)(L + DL_KT + img128(dk, 2 * ks + hp)); }
            if (x < 128) { const int d = x >> 6, t = x & 63; float* SC = (float*)((unsigned char*)F.out + OUT_SC) + (size_t)(bhc * 2 + d) * SC_FLOATS;
                const float gc = GCN[d * 64 + t], gl = GLs[d]; SC[t] = RQ[t] * __expf(gc); SC[64 + t] = RK[t] * __expf(gl - gc); if (t == 0) SC[128] = __expf(gl); }
        }
        __syncthreads();
        { const int d = wave >> 2, kind = (wave >> 1) & 1, half = wave & 1;
          unsigned char* PD = F.ws + WS_PD + (size_t)(bhc * 2 + d) * PD_BYTES;
          const LAS unsigned char* TIU = L + DL_TI + d * 16384; const LAS unsigned char* TIW = TIU + 8192;
          if (kind == 0) {
#pragma unroll
              for (int wi = 0; wi < 2; ++wi) { const int w = 2 * half + wi;
#pragma unroll
                  for (int rt = 0; rt < 2; ++rt) { f32x16 acc;
#pragma unroll
                      for (int r = 0; r < 16; ++r) acc[r] = 0.f;
#pragma unroll
                      for (int ks = 0; ks < 4; ++ks) { const bf16x8 af = *(const LAS bf16x8*)(L + DL_KT + img128(32 * w + r32, 2 * ks + hi)), bf = *(const LAS bf16x8*)(TIW + img128(32 * rt + r32, 2 * ks + hi)); acc = MFMA32(af, bf, acc); }
#pragma unroll
                      for (int s = 0; s < 2; ++s) { v4u o; o.x = pk2(acc[8 * s], acc[8 * s + 1]); o.y = pk2(acc[8 * s + 2], acc[8 * s + 3]); o.z = pk2(acc[8 * s + 4], acc[8 * s + 5]); o.w = pk2(acc[8 * s + 6], acc[8 * s + 7]);
                          *(GAS v4u*)(PD + ((size_t)(((w * 2 + rt) * 2 + s) * 64 + lane)) * 16) = o; } } }
          } else {
              const int rt = half;
#pragma unroll
              for (int ct = 0; ct < 4; ++ct) { f32x16 acc;
#pragma unroll
                  for (int r = 0; r < 16; ++r) acc[r] = 0.f;
#pragma unroll
                  for (int ks = 0; ks < 4; ++ks) { const bf16x8 af = *(const LAS bf16x8*)(TIU + img128(32 * rt + r32, 2 * ks + hi)), bf = *(const LAS bf16x8*)(L + DL_VT + img128(32 * ct + r32, 2 * ks + hi)); acc = MFMA32(af, bf, acc); }
#pragma unroll
                  for (int g = 0; g < 4; ++g) { v2u o; o.x = pk2(acc[4 * g], acc[4 * g + 1]); o.y = pk2(acc[4 * g + 2], acc[4 * g + 3]);
                      *(GAS v2u*)(PD + 16384 + (size_t)(32 * ct + r32) * 128 + (32 * rt + 8 * g + 4 * hi) * 2) = o; } }
          } }
    }
}

constexpr int SL_SB = 0, SL_VN = 8192, SL_VS = 12288;
__device__ __forceinline__ void dn_scan_phase(Frame& F) {
    LAS unsigned char* L = F.lds;
    const int lane = F.lane, wave = F.wave, r32 = lane & 31, hi = lane >> 5;
    bf16* OFB = (bf16*)(F.ws + WS_OFB);
    for (int u = F.vcu; u < 256; u += F.G) {
        const int dvs = u & 3, d = (u >> 2) & 1, h = (u >> 3) & 3, b = u >> 5;
        __syncthreads();
        f32x16 S;
#pragma unroll
        for (int r = 0; r < 16; ++r) S[r] = 0.f;
        if (wave < 4) { *(LAS v4u*)(L + SL_SB + ((wave * 2 + 0) * 64 + lane) * 16) = (v4u){0u, 0u, 0u, 0u}; *(LAS v4u*)(L + SL_SB + ((wave * 2 + 1) * 64 + lane) * 16) = (v4u){0u, 0u, 0u, 0u}; }
#pragma unroll 1
        for (int n = 0; n < 32; ++n) {
            const int c = d ? 31 - n : n, bhc = (b * 4 + h) * 32 + c;
            const unsigned char* PS = (const unsigned char*)F.out + OUT_PS + (size_t)bhc * PS_BYTES;
            const unsigned char* PD = F.ws + WS_PD + (size_t)(bhc * 2 + d) * PD_BYTES;
            const float* SC = (const float*)((const unsigned char*)F.out + OUT_SC) + (size_t)(bhc * 2 + d) * SC_FLOATS;
            if (wave < 4) {
                bf16x8 kt[4];
#pragma unroll
                for (int ks = 0; ks < 4; ++ks) kt[ks] = *(const GAS bf16x8*)(PS + 16384 + ((size_t)((wave * 4 + ks) * 64 + lane)) * 16);
                const float gl = SC[128];
                BAR_LDS();
                BAR_LDS();
#pragma unroll
                for (int r = 0; r < 16; ++r) S[r] *= gl;
#pragma unroll
                for (int ks = 0; ks < 4; ++ks) { const bf16x8 vs = *(const LAS bf16x8*)(L + SL_VS + (ks * 64 + lane) * 16); S = MFMA32(kt[ks], vs, S); }
                *(LAS bf16x8*)(L + SL_SB + ((wave * 2 + 0) * 64 + lane) * 16) = pack8(S, 0); *(LAS bf16x8*)(L + SL_SB + ((wave * 2 + 1) * 64 + lane) * 16) = pack8(S, 1);
            } else if (wave < 6) {
                const int rt = wave - 4;
                bf16x8 wl[8]; v2u ut[4]; f32x4 ksc[4];
#pragma unroll
                for (int i = 0; i < 8; ++i) wl[i] = *(const GAS bf16x8*)(PD + ((size_t)((((i >> 1) * 2 + rt) * 2 + (i & 1)) * 64 + lane)) * 16);
#pragma unroll
                for (int g = 0; g < 4; ++g) { ut[g] = *(const GAS v2u*)(PD + 16384 + (size_t)(32 * dvs + r32) * 128 + (32 * rt + 8 * g + 4 * hi) * 2); ksc[g] = *(const GAS f32x4*)(SC + 64 + 32 * rt + 8 * g + 4 * hi); }
                BAR_LDS();
                f32x16 acc;
#pragma unroll
                for (int r = 0; r < 16; ++r) acc[r] = 0.f;
#pragma unroll
                for (int i = 0; i < 8; ++i) { const bf16x8 sb = *(const LAS bf16x8*)(L + SL_SB + (i * 64 + lane) * 16); acc = MFMA32(wl[i], sb, acc); }
#pragma unroll
                for (int g = 0; g < 4; ++g) { const float u0 = bflo(ut[g].x) - acc[4 * g], u1 = bfhi(ut[g].x) - acc[4 * g + 1], u2 = bflo(ut[g].y) - acc[4 * g + 2], u3 = bfhi(ut[g].y) - acc[4 * g + 3];
                    const int off = ((2 * rt + (g >> 1)) * 64 + r32 + 32 * (g & 1)) * 16 + 8 * hi;
                    v2u a; a.x = cvtpk(u0, u1); a.y = cvtpk(u2, u3); *(LAS v2u*)(L + SL_VN + off) = a;
                    v2u s2; s2.x = cvtpk(u0 * ksc[g].x, u1 * ksc[g].y); s2.y = cvtpk(u2 * ksc[g].z, u3 * ksc[g].w); *(LAS v2u*)(L + SL_VS + off) = s2; }
                BAR_LDS();
            } else {
                const int rt = wave - 6;
                bf16x8 ql[8], qk[4]; f32x4 rsc[4];
#pragma unroll
                for (int i = 0; i < 8; ++i) ql[i] = *(const GAS bf16x8*)(PS + ((size_t)((((i >> 1) * 2 + rt) * 2 + (i & 1)) * 64 + lane)) * 16);
#pragma unroll
                for (int ks = 0; ks < 4; ++ks) qk[ks] = *(const GAS bf16x8*)(PD + 32768 + ((size_t)((rt * 4 + ks) * 64 + lane)) * 16);
#pragma unroll
                for (int g = 0; g < 4; ++g) rsc[g] = *(const GAS f32x4*)(SC + 32 * rt + 8 * g + 4 * hi);
                BAR_LDS();
                f32x16 acc;
#pragma unroll
                for (int r = 0; r < 16; ++r) acc[r] = 0.f;
#pragma unroll
                for (int i = 0; i < 8; ++i) { const bf16x8 sb = *(const LAS bf16x8*)(L + SL_SB + (i * 64 + lane) * 16); acc = MFMA32(ql[i], sb, acc); }
#pragma unroll
                for (int g = 0; g < 4; ++g) { acc[4 * g] *= rsc[g].x; acc[4 * g + 1] *= rsc[g].y; acc[4 * g + 2] *= rsc[g].z; acc[4 * g + 3] *= rsc[g].w; }
                BAR_LDS();
#pragma unroll
                for (int ks = 0; ks < 4; ++ks) { const bf16x8 vn = *(const LAS bf16x8*)(L + SL_VN + (ks * 64 + lane) * 16); acc = MFMA32(qk[ks], vn, acc); }
                bf16* op = OFB + ((size_t)d * M + (size_t)b * 2048 + 64 * c + 32 * rt) * 512 + h * 128 + 32 * dvs + r32;
#pragma unroll
                for (int r = 0; r < 16; ++r) op[(size_t)crow(r, hi) * 512] = (bf16)f2bf(acc[r]);
            }
        }
    }
}
namespace simple {
__device__ __forceinline__ float wmax(float v) {
#pragma unroll
    for (int o = 1; o < 64; o <<= 1) v = fmaxf(v, __shfl_xor(v, o));
    return v;
}
__global__ void __launch_bounds__(256) wattn_k(const bf16* __restrict__ QA, const bf16* __restrict__ KA, const bf16* __restrict__ VA, const float* __restrict__ sink, bf16* __restrict__ mix) {
    __shared__ float pbuf[4][320];
    __shared__ float qbuf[4][64];
    const int w = threadIdx.x >> 6, lane = threadIdx.x & 63;
    const int item = blockIdx.x * 4 + w, tok = item >> 3, hq = item & 7, kvh = hq >> 2;
    const int b = tok / SEQ, i = tok % SEQ;
    qbuf[w][lane] = bf2f(QA[(size_t)tok * 512 + hq * 64 + lane]);
    __syncthreads();
    const int jlo = i - 128; const float sinkl = sink[hq] * LOG2E;
    float sc[5]; float mx = sinkl;
#pragma unroll
    for (int r = 0; r < 5; ++r) { const int jj = lane + 64 * r, j = jlo + jj; sc[r] = -INFINITY;
        if (jj <= 256 && j >= 0 && j < SEQ) { const bf16* kp = KA + (size_t)(b * SEQ + j) * 128 + kvh * 64; float s = 0.f;
            for (int d = 0; d < 64; ++d) s = fmaf(qbuf[w][d], bf2f(kp[d]), s);
            sc[r] = s; mx = fmaxf(mx, s); } }
    mx = wmax(mx);
    float den = 0.f;
#pragma unroll
    for (int r = 0; r < 5; ++r) { const int jj = lane + 64 * r; const float p = (sc[r] == -INFINITY) ? 0.f : exp2f(sc[r] - mx); if (jj < 320) pbuf[w][jj] = p; den += p; }
    den = wave_sum(den) + exp2f(sinkl - mx);
    __syncthreads();
    float o = 0.f;
    for (int jj = 0; jj <= 256; ++jj) { const int j = jlo + jj; if (j >= 0 && j < SEQ) o = fmaf(pbuf[w][jj], bf2f(VA[(size_t)(b * SEQ + j) * 128 + kvh * 64 + lane]), o); }
    mix[(size_t)tok * D + hq * 64 + lane] = (bf16)f2bf(o / den);
}
__global__ void __launch_bounds__(128) dn_k(const bf16* __restrict__ DQ, const float* __restrict__ conv_w, const float* __restrict__ gb, bf16* __restrict__ O) {
    __shared__ __attribute__((aligned(16))) float sk[128];
    __shared__ __attribute__((aligned(16))) float sq[128];
    __shared__ float red[2][2];
    const int j = threadIdx.x, blk = blockIdx.x, dir = blk & 1, h = (blk >> 1) & 3, b = blk >> 3;
    const int cq = h * 128 + j, ck = cq + 512, cv = cq + 1024;
    float wq[5], wk[5], wv[5];
#pragma unroll
    for (int w = 0; w < 5; ++w) { wq[w] = conv_w[w * 1536 + cq]; wk[w] = conv_w[w * 1536 + ck]; wv[w] = conv_w[w * 1536 + cv]; }
    const float* gp = gb + ((size_t)(dir * 8 + b) * 4 + h) * 2048; const float* bp = gp + 131072;
    float St[128];
#pragma unroll
    for (int i = 0; i < 128; ++i) St[i] = 0.f;
    for (int step = 0; step < SEQ; ++step) {
        const int t = dir ? (SEQ - 1 - step) : step;
        float q = 0.f, k = 0.f, v = 0.f;
#pragma unroll
        for (int w = 0; w < 5; ++w) { const int tt = t + w - 2; if (tt >= 0 && tt < SEQ) { const bf16* r2 = DQ + (size_t)(b * SEQ + tt) * 1536; q = fmaf(bf2f(r2[cq]), wq[w], q); k = fmaf(bf2f(r2[ck]), wk[w], k); v = fmaf(bf2f(r2[cv]), wv[w], v); } }
        q = q / (1.f + expf(-q)); k = k / (1.f + expf(-k)); v = v / (1.f + expf(-v));
        const float e = expf(gp[t]), beta = bp[t];
        float s1 = wave_sum(q * q), s2 = wave_sum(k * k);
        if ((j & 63) == 0) { red[j >> 6][0] = s1; red[j >> 6][1] = s2; }
        __syncthreads();
        const float ssq = red[0][0] + red[1][0], ssk = red[0][1] + red[1][1];
        sq[j] = q * rsqrtf(ssq + EPS) * 0.08838834764831845f; sk[j] = k * rsqrtf(ssk + EPS);
        __syncthreads();
        float dot = 0.f;
#pragma unroll
        for (int i4 = 0; i4 < 32; ++i4) { const float4 kk = ((const float4*)sk)[i4]; dot = fmaf(kk.x, St[4 * i4], dot); dot = fmaf(kk.y, St[4 * i4 + 1], dot); dot = fmaf(kk.z, St[4 * i4 + 2], dot); dot = fmaf(kk.w, St[4 * i4 + 3], dot); }
        const float c = beta * (v - e * dot);
        float o = 0.f;
#pragma unroll
        for (int i4 = 0; i4 < 32; ++i4) { const float4 kk = ((const float4*)sk)[i4]; const float4 qq = ((const float4*)sq)[i4];
            St[4 * i4] = fmaf(e, St[4 * i4], kk.x * c); o = fmaf(qq.x, St[4 * i4], o);
            St[4 * i4 + 1] = fmaf(e, St[4 * i4 + 1], kk.y * c); o = fmaf(qq.y, St[4 * i4 + 1], o);
            St[4 * i4 + 2] = fmaf(e, St[4 * i4 + 2], kk.z * c); o = fmaf(qq.z, St[4 * i4 + 2], o);
            St[4 * i4 + 3] = fmaf(e, St[4 * i4 + 3], kk.w * c); o = fmaf(qq.w, St[4 * i4 + 3], o); }
        O[((size_t)dir * M + (size_t)(b * SEQ + t)) * 512 + h * 128 + j] = (bf16)f2bf(o);
    }
}
__global__ void __launch_bounds__(256) cattn_k(const bf16* __restrict__ QC, const bf16* __restrict__ KC, const bf16* __restrict__ VCT, bf16* __restrict__ OC) {
    __shared__ float qb[4][256];
    __shared__ float pb[4][256];
    const int w = threadIdx.x >> 6, lane = threadIdx.x & 63;
    const int item = blockIdx.x * 4 + w, tok = item >> 2, hd = item & 3, b = tok / SEQ;
    for (int i = 0; i < 4; ++i) qb[w][lane + 64 * i] = bf2f(QC[(size_t)tok * D + hd * 256 + lane + 64 * i]);
    __syncthreads();
    float sc[4], mx = -INFINITY;
#pragma unroll
    for (int r = 0; r < 4; ++r) { const int key = lane + 64 * r; const bf16* kp = KC + (size_t)(b * MEMLEN + key) * 1024 + hd * 256; float s = 0.f;
        for (int d = 0; d < 256; ++d) s = fmaf(qb[w][d], bf2f(kp[d]), s);
        sc[r] = s; mx = fmaxf(mx, s); }
    mx = wmax(mx);
    float den = 0.f;
#pragma unroll
    for (int r = 0; r < 4; ++r) { const float p = exp2f(sc[r] - mx); pb[w][lane + 64 * r] = p; den += p; }
    den = wave_sum(den);
    __syncthreads();
#pragma unroll
    for (int r = 0; r < 4; ++r) { const int d = lane + 64 * r; const bf16* vp = VCT + (size_t)(hd * 256 + d) * 2048 + b * MEMLEN; float acc = 0.f;
        for (int key = 0; key < 256; ++key) acc = fmaf(pb[w][key], bf2f(vp[key]), acc);
        OC[(size_t)tok * D + hd * 256 + d] = (bf16)f2bf(acc / den); }
}
}
__global__ void __launch_bounds__(NWAVES * 64, 2) mk_fwd(Args args) {
    extern __shared__ __attribute__((aligned(16))) unsigned char lds[];
    Frame F;
    F.lds = (LAS unsigned char*)lds; F.MISC = (volatile LAS unsigned*)(F.lds + MISC_OFF);
    F.tid = threadIdx.x; F.lane = F.tid & 63; F.wave = __builtin_amdgcn_readfirstlane(F.tid >> 6);
    F.G = gridDim.x; { const int bx = blockIdx.x; F.vcu = (F.G % 8 == 0) ? (bx % 8) * (F.G / 8) + bx / 8 : bx; }
    F.ws = args.ws; F.out = args.out; F.ctl = (gu32*)(args.ws + WS_CTL);
    for (int u = F.tid; u < (LDS_BYTES - LDSCTL_OFF) / 4; u += NWAVES * 64) ((LAS unsigned*)(F.lds + LDSCTL_OFF))[u] = 0u;
    __syncthreads();
    const int lo = args.ph_lo, hi = args.ph_hi;
    XcdBarrier bar; bar.bar = (unsigned*)(F.ctl + CW_BAR); bar.x = 0; bar.st = nullptr;
    if (hi - lo > 1) bar = xcd_barrier_post((unsigned*)(F.ctl + CW_BAR), F.MISC + 8);
#define IN(k) (lo <= (k) && (k) < hi)
#define SEAM(k) do { if (IN(k) && IN((k) + 1)) xcd_barrier(bar); } while (0)
    unsigned char* ws = args.ws;
    if (IN(0)) { p0_prologue(F, args); } SEAM(0);
    if (IN(1)) { pg8::Gemm g{(const pg8::bf16_t*)(ws + WS_REG1), (const pg8::bf16_t*)(ws + WS_REG1), 0, 0, D}; SchedP1 S{F.G, (int)blockIdx.x}; EpiP1 E{ws};
        pg8::gemm_phase<EpiP1, SchedP1, true, true>(F.lds + RING_OFF, g, S, E); } SEAM(1);
    if (IN(2)) { window_attn_phase(F, (const float*)args.in[9]); dn_prep_phase(F, (const float*)args.in[5]); } SEAM(2);
    if (IN(3)) { dn_scan_phase(F); } SEAM(3);
    if (IN(4)) { dn_combine(F, (const float*)args.in[8]); } SEAM(4);
    if (IN(5)) { pg8::Gemm g{(const pg8::bf16_t*)(ws + WS_MIX), (const pg8::bf16_t*)(ws + WS_WOUT), M, D, D}; pg8::StaticOrder S; S.init(M, D, F.G, (int)blockIdx.x); EpiPlain E{(bf16*)(ws + WS_MIXO), D, 1.f};
        pg8::gemm_phase<EpiPlain, pg8::StaticOrder, true, true>(F.lds + RING_OFF, g, S, E); } SEAM(5);
    if (IN(6)) { row_pass(F, (const float*)args.in[0], (const bf16*)(ws + WS_MIXO), (const float*)args.in[11], F.out, (bf16*)(ws + WS_REG1)); } SEAM(6);
    if (IN(7)) { pg8::Gemm g{(const pg8::bf16_t*)(ws + WS_REG1), (const pg8::bf16_t*)(ws + WS_WCQ), M, D, D}; pg8::StaticOrder S; S.init(M, D, F.G, (int)blockIdx.x); EpiPlain E{(bf16*)(ws + WS_QC), D, QSCALE_C};
        pg8::gemm_phase<EpiPlain, pg8::StaticOrder, true, true>(F.lds + RING_OFF, g, S, E); } SEAM(7);
    if (IN(8)) { cross_attn_phase(F); } SEAM(8);
    if (IN(9)) { pg8::Gemm g{(const pg8::bf16_t*)(ws + WS_OC), (const pg8::bf16_t*)(ws + WS_WCO), M, D, D}; pg8::StaticOrder S; S.init(M, D, F.G, (int)blockIdx.x); EpiPlain E{(bf16*)(ws + WS_CC), D, 1.f};
        pg8::gemm_phase<EpiPlain, pg8::StaticOrder, true, true>(F.lds + RING_OFF, g, S, E); } SEAM(9);
    if (IN(10)) { row_pass(F, F.out, (const bf16*)(ws + WS_CC), (const float*)args.in[17], F.out, (bf16*)(ws + WS_REG1)); } SEAM(10);
    if (IN(11)) { pg8::Gemm g{(const pg8::bf16_t*)(ws + WS_REG1), (const pg8::bf16_t*)(ws + WS_WGU), M, 2 * DFF, D}; pg8::StaticOrder S; S.init(M, 2 * DFF, F.G, (int)blockIdx.x); EpiSwiglu E{(bf16*)(ws + WS_ACT)};
        pg8::gemm_phase<EpiSwiglu, pg8::StaticOrder, true, true>(F.lds + RING_OFF, g, S, E); } SEAM(11);
    if (IN(12)) { pg8::Gemm g{(const pg8::bf16_t*)(ws + WS_ACT), (const pg8::bf16_t*)(ws + WS_WDOWN), M, D, DFF}; pg8::StaticOrder S; S.init(M, D, F.G, (int)blockIdx.x); EpiPlain E{(bf16*)(ws + WS_FF), D, 1.f};
        pg8::gemm_phase<EpiPlain, pg8::StaticOrder, true, true>(F.lds + RING_OFF, g, S, E); } SEAM(12);
    if (IN(13)) { row_pass(F, F.out, (const bf16*)(ws + WS_FF), (const float*)args.in[21], F.out, nullptr); }
#undef IN
#undef SEAM
}

extern "C" void kernel_launch(void* const* d_in, const int* in_sizes, int n_in, void* d_out, int out_size, void* d_ws, size_t ws_size, hipStream_t stream) {
    static int grid = 0;
    if (grid == 0) {
        int dev = 0, cus = 0;
        if (hipGetDevice(&dev) != hipSuccess || hipDeviceGetAttribute(&cus, hipDeviceAttributeMultiprocessorCount, dev) != hipSuccess) { fprintf(stderr, "kernel_launch: device query failed\n"); grid = -1; return; }
        if (hipFuncSetAttribute((const void*)mk_fwd, hipFuncAttributeMaxDynamicSharedMemorySize, LDS_BYTES) != hipSuccess) { fprintf(stderr, "kernel_launch: hipFuncSetAttribute failed\n"); grid = -1; return; }
        (void)hipGetLastError();
        grid = cus;
        if (ws_size < WS_END) { fprintf(stderr, "kernel_launch: workspace too small\n"); grid = -1; return; }
    }
    if (grid < 0) return;
    (void)hipMemsetAsync((char*)d_ws + WS_CTL, 0, CTL_ZERO_BYTES, stream);
    Args a{};
    for (int i = 0; i < 22; ++i) a.in[i] = d_in[i];
    a.out = (float*)d_out; a.ws = (unsigned char*)d_ws;
    auto mk = [&](int lo, int hi) { a.ph_lo = lo; a.ph_hi = hi; hipLaunchKernelGGL(mk_fwd, dim3(grid), dim3(NWAVES * 64), LDS_BYTES, stream, a); };
    mk(0, 14);
}
```

```cpp
#include <hip/hip_runtime.h>
#include <cstdio>
#include <cstdint>
#include <math.h>
namespace pg8 {
#define PG8_LAS __attribute__((address_space(3)))
typedef unsigned short bf16_t;
typedef short bf16x8 __attribute__((ext_vector_type(8)));
typedef float f32x4 __attribute__((ext_vector_type(4)));
typedef unsigned u32x4 __attribute__((ext_vector_type(4)));
constexpr int BM = 256, BK = 64, HALF = 128, HTB = HALF * BK * 2  , STAGE_BYTES = 8 * HTB, NXCD = 8, WGM = 8;

__host__ __device__ __forceinline__ int lds_byte(int r, int c) { const int st = (r >> 4) * 2 + (c >> 5), rr = r & 15, cc = c & 31, ob = rr * 64 + cc * 2; return st * 1024 + (ob ^ (((ob >> 9) & 1) << 5)); }
__host__ __device__ __forceinline__ void stage_rc(int b, int& R, int& C) { const int st = b / 1024, sb = b % 1024, swz = sb ^ (((sb >> 9) & 1) << 5); R = (st >> 1) * 16 + swz / 64; C = (st & 1) * 32 + (swz % 64) / 2; }
__host__ __device__ __forceinline__ int perm32(int rho) { const int n = rho >> 4, i = rho & 15; return 8 * (i >> 2) + 4 * n + (i & 3); }

struct Unit { int pm, pn; };
struct Gemm { const bf16_t* A; const bf16_t* Bt; int M, N, K; };

struct StaticOrder {
    int nM, nN, nwg, G, c;
    __host__ __device__ void init(int M, int N, int G_, int c_) { nM = M / BM; nN = N / BM; nwg = nM * nN; G = G_; c = c_; }
    __host__ __device__ bool next(int i, Unit& u) const {
        const long L = (long)i * G + c; if (L >= nwg) return false;
        int wgid = (int)L; { const int q = nwg / NXCD, r = nwg % NXCD, xcd = wgid % NXCD, off = wgid / NXCD; wgid = (xcd < r ? xcd * (q + 1) : r * (q + 1) + (xcd - r) * q) + off; }
        const int nig = WGM * nN, gid = wgid / nig, fm = gid * WGM, gsz = (nM - fm) < WGM ? (nM - fm) : WGM;
        u.pm = fm + ((wgid % nig) % gsz); u.pn = (wgid % nig) / gsz; return true;
    }
    __device__ __forceinline__ void a_ready(const Unit&) const {}
    __device__ __forceinline__ void done(const Unit&) const {}
};

__device__ __forceinline__ unsigned cvt_pk_bf16(float lo, float hi) { unsigned r; asm volatile("v_cvt_pk_bf16_f32 %0, %1, %2" : "=v"(r) : "v"(lo), "v"(hi)); return r; }
template <class Epi, class Sched, bool ALIGN_EPI = false, bool SP2 = false>
__device__ __forceinline__ void gemm_phase(PG8_LAS unsigned char* lds, const Gemm g, const Sched& S, const Epi& E) {
    const int tid = threadIdx.x, wid = __builtin_amdgcn_readfirstlane(tid >> 6), lane = tid & 63, wr = wid >> 2, wc = wid & 3, fr = lane & 15, fq = lane >> 4;
    const int K = g.K, nt = K / BK;
    unsigned voffA[2], voffB[2];
#pragma unroll
    for (int i = 0; i < 2; ++i) { int R, C; stage_rc(tid * 16 + i * 8192, R, C); const int Rb = Epi::PERM ? ((R & ~31) + perm32(R & 31)) : R;
        voffA[i] = (unsigned)(R * K + C) * 2u; voffB[i] = (unsigned)(Rb * K + C) * 2u; }
    const size_t kstep = (size_t)(BK * 2);
    const size_t hstep = (size_t)HALF * K * 2;
    const size_t tstep = 2 * hstep;
    const unsigned ldsw = (unsigned)wid * 1024u;
    const int aoff = lds_byte(wr * 64 + fr, fq * 8), boff = lds_byte(wc * 32 + fr, fq * 8);
#define PG8_SA(b, h) (((b) * 2 + (h)) * HTB)
#define PG8_SB(b, h) ((4 + (b) * 2 + (h)) * HTB)
#define PG8_STAGE(bufoff, gbase, voff) do { _Pragma("unroll") for (int _i = 0; _i < 2; ++_i) \
        __builtin_amdgcn_global_load_lds((const unsigned*)((const char*)(gbase) + (voff)[_i]), (PG8_LAS unsigned*)(lds + (bufoff) + ldsw + _i * 8192), 16, 0, 0); } while (0)
#define PG8_LDA(dst, b, h) do { _Pragma("unroll") for (int m = 0; m < 4; ++m) _Pragma("unroll") for (int k = 0; k < 2; ++k) dst[m][k] = *(const PG8_LAS bf16x8*)(lds + PG8_SA(b, h) + aoff + m * 2048 + k * 1024); } while (0)
#define PG8_LDB(dst, b, h) do { _Pragma("unroll") for (int n = 0; n < 2; ++n) _Pragma("unroll") for (int k = 0; k < 2; ++k) dst[n][k] = *(const PG8_LAS bf16x8*)(lds + PG8_SB(b, h) + boff + n * 2048 + k * 1024); } while (0)
#define PG8_MMA(ai, bj, At, Bt) do { __builtin_amdgcn_s_setprio(1); _Pragma("unroll") for (int m = 0; m < 4; ++m) _Pragma("unroll") for (int n = 0; n < 2; ++n) _Pragma("unroll") for (int k = 0; k < 2; ++k) \
        acc[ai][bj][m][n] = __builtin_amdgcn_mfma_f32_16x16x32_bf16(Bt[n][k], At[m][k], acc[ai][bj][m][n], 0, 0, 0); __builtin_amdgcn_s_setprio(0); } while (0)
#define PG8_WAIT_V(n) asm volatile("s_waitcnt vmcnt(" #n ")" ::: "memory")
#define PG8_WAIT_L(n) asm volatile("s_waitcnt lgkmcnt(" #n ")" ::: "memory")
#define PG8_BAR __builtin_amdgcn_s_barrier()
#define PG8_SCHED __builtin_amdgcn_sched_barrier(0)
    Unit cur, nxt; int ui = 0;
    if (!S.next(0, cur)) return;
    f32x4 acc[2][2][4][2];
#pragma unroll
    for (int a = 0; a < 2; ++a)
#pragma unroll
        for (int b = 0; b < 2; ++b)
#pragma unroll
            for (int m = 0; m < 4; ++m)
#pragma unroll
                for (int n = 0; n < 2; ++n) acc[a][b][m][n] = (f32x4){0.f, 0.f, 0.f, 0.f};
    bf16x8 At[4][2], B0[2][2], B1[2][2];
    const char* cA = (const char*)g.A + (size_t)cur.pm * tstep; const char* cB = (const char*)g.Bt + (size_t)cur.pn * tstep;
    S.a_ready(cur);
    if constexpr (SP2) {
        PG8_STAGE(PG8_SB(0, 0), cB, voffB); PG8_STAGE(PG8_SB(0, 1), cB + hstep, voffB); PG8_STAGE(PG8_SA(0, 0), cA, voffA); PG8_STAGE(PG8_SA(0, 1), cA + hstep, voffA);
        if (wr == 1) PG8_BAR;
        PG8_WAIT_V(2); PG8_BAR;
        PG8_STAGE(PG8_SB(1, 0), cB + kstep, voffB); PG8_STAGE(PG8_SA(1, 0), cA + kstep, voffA); PG8_STAGE(PG8_SB(1, 1), cB + hstep + kstep, voffB);
        PG8_WAIT_V(6); PG8_BAR;
    } else {
        PG8_STAGE(PG8_SB(0, 0), cB, voffB); PG8_STAGE(PG8_SA(0, 0), cA, voffA); PG8_STAGE(PG8_SB(0, 1), cB + hstep, voffB); PG8_STAGE(PG8_SA(0, 1), cA + hstep, voffA);
        if (wr == 1) PG8_BAR;
        PG8_WAIT_V(4); PG8_BAR;
        PG8_STAGE(PG8_SB(1, 0), cB + kstep, voffB); PG8_STAGE(PG8_SA(1, 0), cA + kstep, voffA); PG8_STAGE(PG8_SB(1, 1), cB + hstep + kstep, voffB);
        PG8_WAIT_V(6); PG8_BAR;
    }
    for (;;) {
        const bool has_next = S.next(ui + 1, nxt);
        const char* nA = has_next ? (const char*)g.A + (size_t)nxt.pm * tstep : cA; const char* nB = has_next ? (const char*)g.Bt + (size_t)nxt.pn * tstep : cB;
        for (int t = 0; t < nt; t += 2) {
            const bool last = (t == nt - 2);
            const char* a1 = cA + (size_t)(t + 1) * kstep;
            const char* a2 = last ? nA : cA + (size_t)(t + 2) * kstep; const char* b2 = last ? nB : cB + (size_t)(t + 2) * kstep;
            const char* a3 = a2 + kstep; const char* b3 = b2 + kstep;
            if (last && has_next) S.a_ready(nxt);
            if constexpr (SP2) {
            PG8_LDB(B0, 0, 0); PG8_LDB(B1, 0, 1); PG8_SCHED; PG8_LDA(At, 0, 0); PG8_STAGE(PG8_SA(1, 1), a1 + hstep, voffA);
            PG8_WAIT_V(8); PG8_WAIT_L(0); PG8_BAR; PG8_MMA(0, 0, At, B0); PG8_MMA(0, 1, At, B1); PG8_BAR; PG8_SCHED;
            PG8_LDA(At, 0, 1); PG8_STAGE(PG8_SB(0, 0), b2, voffB); PG8_STAGE(PG8_SB(0, 1), b2 + hstep, voffB); PG8_STAGE(PG8_SA(0, 0), a2, voffA);
            PG8_WAIT_V(8); PG8_WAIT_L(0); PG8_BAR; PG8_MMA(1, 0, At, B0); PG8_MMA(1, 1, At, B1); PG8_BAR; PG8_SCHED;
            PG8_LDB(B0, 1, 0); PG8_LDB(B1, 1, 1); PG8_SCHED; PG8_LDA(At, 1, 0); PG8_STAGE(PG8_SA(0, 1), a2 + hstep, voffA);
            PG8_WAIT_V(8); PG8_WAIT_L(0); PG8_BAR; PG8_MMA(0, 0, At, B0); PG8_MMA(0, 1, At, B1); PG8_BAR; PG8_SCHED;
            PG8_LDA(At, 1, 1); PG8_STAGE(PG8_SB(1, 0), b3, voffB); PG8_STAGE(PG8_SB(1, 1), b3 + hstep, voffB); PG8_STAGE(PG8_SA(1, 0), a3, voffA);
            PG8_WAIT_V(8); PG8_WAIT_L(0); PG8_BAR; PG8_MMA(1, 0, At, B0); PG8_MMA(1, 1, At, B1); PG8_BAR; PG8_SCHED;
            } else {
            PG8_LDB(B0, 0, 0); PG8_SCHED; PG8_LDA(At, 0, 0); PG8_STAGE(PG8_SA(1, 1), a1 + hstep, voffA);
            PG8_WAIT_L(8); PG8_BAR; PG8_WAIT_L(0); PG8_MMA(0, 0, At, B0); PG8_BAR; PG8_SCHED;
            PG8_LDB(B1, 0, 1); PG8_STAGE(PG8_SB(0, 0), b2, voffB);
            PG8_BAR; PG8_WAIT_L(0); PG8_MMA(0, 1, At, B1); PG8_BAR;
            PG8_LDA(At, 0, 1); PG8_STAGE(PG8_SA(0, 0), a2, voffA);
            PG8_BAR; PG8_WAIT_L(0); PG8_MMA(1, 0, At, B0); PG8_BAR; PG8_SCHED;
            PG8_STAGE(PG8_SB(0, 1), b2 + hstep, voffB);
            PG8_WAIT_V(6); PG8_BAR; PG8_MMA(1, 1, At, B1); PG8_BAR;
            PG8_LDB(B0, 1, 0); PG8_SCHED; PG8_LDA(At, 1, 0); PG8_STAGE(PG8_SA(0, 1), a2 + hstep, voffA);
            PG8_WAIT_L(8); PG8_BAR; PG8_WAIT_L(0); PG8_MMA(0, 0, At, B0); PG8_BAR; PG8_SCHED;
            PG8_LDB(B1, 1, 1); PG8_STAGE(PG8_SB(1, 0), b3, voffB);
            PG8_BAR; PG8_WAIT_L(0); PG8_MMA(0, 1, At, B1); PG8_BAR;
            PG8_LDA(At, 1, 1); PG8_STAGE(PG8_SA(1, 0), a3, voffA);
            PG8_BAR; PG8_WAIT_L(0); PG8_MMA(1, 0, At, B0); PG8_BAR; PG8_SCHED;
            PG8_STAGE(PG8_SB(1, 1), b3 + hstep, voffB);
            PG8_WAIT_V(6); PG8_BAR; PG8_MMA(1, 1, At, B1); PG8_BAR;
            }
        }
        if constexpr (ALIGN_EPI) { if (wr == 0) PG8_BAR; }
        if constexpr (!Epi::AFTER_DRAIN) { E(acc, cur, wr, wc, fr, fq); S.done(cur); }
        if (!has_next) break;
#pragma unroll
        for (int a = 0; a < 2; ++a)
#pragma unroll
            for (int b = 0; b < 2; ++b)
#pragma unroll
                for (int m = 0; m < 4; ++m)
#pragma unroll
                    for (int n = 0; n < 2; ++n) acc[a][b][m][n] = (f32x4){0.f, 0.f, 0.f, 0.f};
        cur = nxt; cA = nA; cB = nB; ++ui;
        if constexpr (ALIGN_EPI) { if (wr == 1) PG8_BAR; }
    }
    PG8_WAIT_V(0);
    if constexpr (!ALIGN_EPI) { if (wr == 0) PG8_BAR; }
    PG8_BAR;
    if constexpr (Epi::AFTER_DRAIN) { E.fused(acc, cur, wr, wc, fr, fq, lds, wid, lane); S.done(cur); }
#undef PG8_SA
#undef PG8_SB
#undef PG8_STAGE
#undef PG8_LDA
#undef PG8_LDB
#undef PG8_MMA
#undef PG8_WAIT_V
#undef PG8_WAIT_L
#undef PG8_BAR
#undef PG8_SCHED
}
}
#define GAS __attribute__((address_space(1)))
#define LAS __attribute__((address_space(3)))
typedef unsigned short bf16;
typedef unsigned v4u __attribute__((ext_vector_type(4))); typedef unsigned v2u __attribute__((ext_vector_type(2)));
typedef float f32x4 __attribute__((ext_vector_type(4)));
typedef short bf16x8 __attribute__((ext_vector_type(8)));
typedef GAS unsigned gu32;
typedef GAS unsigned long long gu64;
#define RLX_AGENT __ATOMIC_RELAXED, __HIP_MEMORY_SCOPE_AGENT
#define LDS_WAIT() asm volatile("s_waitcnt lgkmcnt(0)" ::: "memory")
#define VM_WAIT() asm volatile("s_waitcnt vmcnt(0)" ::: "memory")
__device__ __forceinline__ unsigned long long rt() { return __builtin_amdgcn_s_memrealtime(); }
typedef float f32x2h_t __attribute__((ext_vector_type(2))); typedef __bf16 bf16x2h_t __attribute__((ext_vector_type(2)));
__device__ __forceinline__ unsigned pk2(float lo, float hi) { f32x2h_t v = {lo, hi}; bf16x2h_t b = __builtin_convertvector(v, bf16x2h_t); return __builtin_bit_cast(unsigned, b); }
__device__ __forceinline__ unsigned f2bf(float f) { return pk2(f, f) & 0xffffu; }

#define XB_TMO      128
#define XB_XCNT(j)  (256  + 64 * (j))
#define XB_XSUB(j)  (1280 + 64 * (j))
#define XB_XGEN(j)  (2304 + 64 * (j))
#define XB_TOP      3328
#define XB_TOPGEN   3392
#define XCD_BAR_WORDS 3456
#define XB_SPIN_CAP (1u << 18)

__device__ __forceinline__ unsigned xb_ld(unsigned* p)              { return __hip_atomic_load(p, __ATOMIC_RELAXED, __HIP_MEMORY_SCOPE_AGENT); }
__device__ __forceinline__ unsigned xb_add(unsigned* p, unsigned v) { return __hip_atomic_fetch_add(p, v, __ATOMIC_RELAXED, __HIP_MEMORY_SCOPE_AGENT); }
__device__ __forceinline__ unsigned xb_xcc_id() { return (unsigned)__builtin_amdgcn_s_getreg((3 << 11) | 20) & 0xFu; }
#define XB_SPIN(cond, bar) do { unsigned _sp = 0; while (cond) { __builtin_amdgcn_s_sleep(1); \
    if ((++_sp & 255u) == 0u) { if (xb_ld(&(bar)[XB_TMO])) break; if (_sp > XB_SPIN_CAP) { atomicAdd(&(bar)[XB_TMO], 1u); break; } } } } while (0)

struct XcdBarrier {
    unsigned* bar; unsigned x;
    volatile LAS unsigned* st;
};

__device__ __forceinline__ XcdBarrier xcd_barrier_post(unsigned* bar, volatile LAS unsigned* st) {
    XcdBarrier b; b.bar = bar; b.x = xb_xcc_id(); b.st = st;
    if (threadIdx.x == 0) (void)xb_add(&bar[XB_XCNT(b.x)], 1u);
    return b;
}
__device__ __forceinline__ void xcd_barrier_complete(unsigned* bar, unsigned x, unsigned& nloc, unsigned& nx) {
    const unsigned G = gridDim.x * gridDim.y * gridDim.z;
    unsigned sum, cnt, mine, sp = 0u;
    for (;;) {
        sum = 0u; cnt = 0u; mine = 0u;
#pragma unroll
        for (unsigned j = 0; j < 16; ++j) { const unsigned c = xb_ld(&bar[XB_XCNT(j)]); sum += c; cnt += (c > 0u) ? 1u : 0u; mine = (j == x) ? c : mine; }
        if (sum == G) break;
        __builtin_amdgcn_s_sleep(1);
        if ((++sp & 255u) == 0u) { if (xb_ld(&bar[XB_TMO])) break; if (sp > XB_SPIN_CAP) { atomicAdd(&bar[XB_TMO], 1u); break; } }
    }
    nloc = mine > 0u ? mine : 1u; nx = cnt > 0u ? cnt : 1u;
}

__device__ __forceinline__ void xcd_barrier(const XcdBarrier& b) {
    asm volatile("s_waitcnt vmcnt(0)" ::: "memory");
    __syncthreads();
    if (threadIdx.x == 0) {
        unsigned* bar = b.bar;
        __builtin_amdgcn_s_waitcnt(0);
        unsigned nloc = b.st[0], nx = b.st[1];
        if (nloc == 0u) { xcd_barrier_complete(bar, b.x, nloc, nx); b.st[0] = nloc; b.st[1] = nx; }
        const unsigned old = xb_add(&bar[XB_XSUB(b.x)], 1u);
        const unsigned gen = old / nloc;
        if (old + 1u == (gen + 1u) * nloc) {
            __builtin_amdgcn_fence(__ATOMIC_RELEASE, "agent");
            asm volatile("s_waitcnt vmcnt(0)" ::: "memory");
            const unsigned og = xb_add(&bar[XB_TOP], 1u);
            const unsigned tg = og / nx;
            if (og + 1u == (tg + 1u) * nx) xb_add(&bar[XB_TOPGEN], 1u);
            else XB_SPIN(xb_ld(&bar[XB_TOPGEN]) == tg, bar);
            __builtin_amdgcn_fence(__ATOMIC_ACQUIRE, "agent");
            xb_add(&bar[XB_XGEN(b.x)], 1u);
            asm volatile("s_waitcnt vmcnt(0)" ::: "memory");
        } else {
            XB_SPIN(xb_ld(&bar[XB_XGEN(b.x)]) == gen, bar);
            __builtin_amdgcn_fence(__ATOMIC_ACQUIRE, "agent");
            asm volatile("s_waitcnt vmcnt(0)" ::: "memory");
        }
    }
    __syncthreads();
}
constexpr int NWAVES = 8;
constexpr int BATCH = 8, SEQ = 2048, D = 1024, M = BATCH * SEQ, MEMLEN = 256, MMEM = BATCH * MEMLEN;
constexpr int INC = 2832, DFF = 2816;
constexpr float EPS = 1e-6f;
constexpr float LOG2E = 1.4426950408889634f;
constexpr float QSCALE_A = 0.125f * LOG2E;
constexpr float QSCALE_C = 0.0625f * LOG2E;
constexpr size_t MiB = (size_t)1 << 20;
constexpr size_t WS_CTL = 0, CTL_ZERO_BYTES = 1 * MiB;
constexpr size_t WS_GB = 1 * MiB;
constexpr size_t WS_WOUT = 2 * MiB, WS_WCQ = 4 * MiB, WS_WCO = 6 * MiB, WS_WGU = 8 * MiB, WS_WDOWN = 19 * MiB;
constexpr size_t WS_RS = 24 * MiB + 512 * 1024;
constexpr size_t WS_ROPE = 25 * MiB;
constexpr size_t WS_KC = 29 * MiB, WS_VCT = 33 * MiB;
constexpr size_t WS_DGATE = 37 * MiB;
constexpr size_t WS_QA = 53 * MiB, WS_KA = 69 * MiB, WS_VA = 73 * MiB;
constexpr size_t WS_DQKV = 77 * MiB;
constexpr size_t WS_MIX = 125 * MiB;
constexpr size_t WS_REG1 = 157 * MiB;
constexpr int R1_XN = 0, R1_MEMN = 16384, R1_WIN = 18432, R1_WK = 21248, R1_WV = 22272, R1_ROWS = 23296;
constexpr int T_MEMN = R1_MEMN / 256, T_WIN = R1_WIN / 256, T_WK = R1_WK / 256, T_WV = R1_WV / 256;
constexpr size_t WS_PREPB = 157 * MiB;
#ifndef DEV_OFB
#define DEV_OFB 0
#endif
constexpr size_t WS_OFB = (DEV_OFB ? 205 : 53) * MiB;
constexpr size_t WS_MIXO = 85 * MiB;
constexpr size_t WS_QC = 53 * MiB, WS_OC = 85 * MiB, WS_CC = 117 * MiB;
constexpr size_t WS_ACT = 37 * MiB;
constexpr size_t WS_FF = 125 * MiB;
constexpr size_t WS_END = 256 * MiB;
constexpr int CW_TMO = 0, CW_BAR = 4096;
constexpr int RING_OFF = 0, RING_BYTES = 131072;
constexpr int LDSCTL_OFF = 147456 - 512, MISC_OFF = LDSCTL_OFF + 320;
constexpr int LDS_BYTES = 147456;
struct Args { const void* in[22]; float* out; unsigned char* ws; int ph_lo, ph_hi; };
struct Frame {
    LAS unsigned char* lds; volatile LAS unsigned* MISC; gu32* ctl;
    int tid, lane, wave, vcu, G;
    unsigned char* ws; float* out;
};
__device__ __forceinline__ float wave_sum(float v) {
#pragma unroll
    for (int o = 1; o < 64; o <<= 1) v += __shfl_xor(v, o);
    return v;
}
__device__ __forceinline__ float silu_f(float x) { return x / (1.f + __expf(-x)); }
__device__ __forceinline__ float bf2f(unsigned short b) { return __uint_as_float((unsigned)b << 16); }
__device__ __forceinline__ float bflo(unsigned w) { return __uint_as_float(w << 16); }
__device__ __forceinline__ float bfhi(unsigned w) { return __uint_as_float(w & 0xffff0000u); }

__device__ __forceinline__ void p0_transpose_item(const float* W, int ldw, const float* gain, bf16* WT, int ldt, int k0, int n0, int dst_row, LAS float* scr, int lane) {
    const int kq = lane >> 3, n4 = (lane & 7) * 4;
    f32x4 v[8];
#pragma unroll
    for (int i = 0; i < 8; ++i) v[i] = *(const GAS f32x4*)(W + (size_t)(k0 + kq + 8 * i) * ldw + n0 + n4);
#pragma unroll
    for (int i = 0; i < 8; ++i) { const int kk = kq + 8 * i; const float gv = gain ? gain[k0 + kk] : 1.f; LAS float* d = scr + kk * 33 + n4;
        d[0] = v[i].x * gv; d[1] = v[i].y * gv; d[2] = v[i].z * gv; d[3] = v[i].w * gv; }
    LDS_WAIT(); asm volatile("" ::: "memory");
    const int c = lane & 7;
#pragma unroll
    for (int j = 0; j < 4; ++j) { const int n = (lane >> 3) + 8 * j; const LAS float* s = scr + (8 * c) * 33 + n;
        v4u o; o.x = pk2(s[0 * 33], s[1 * 33]); o.y = pk2(s[2 * 33], s[3 * 33]); o.z = pk2(s[4 * 33], s[5 * 33]); o.w = pk2(s[6 * 33], s[7 * 33]);
        *(GAS v4u*)(WT + (size_t)(dst_row + n) * ldt + k0 + 8 * c) = o; }
    LDS_WAIT(); asm volatile("" ::: "memory");
}
__device__ __forceinline__ int map_win(int n0) {
    if (n0 < 512) { const int hq = n0 >> 6, half = (n0 >> 5) & 1; return (hq >> 2) * 256 + half * 128 + (hq & 3) * 32; }
    if (n0 < 640) { const int c = n0 - 512, kh = c >> 6, half = (c >> 5) & 1; return 512 + half * 128 + kh * 32; }
    if (n0 < 768) { const int c = n0 - 640; return 512 + (c >> 6) * 128 + 64 + (c & 63); }
    return n0;
}
__device__ __forceinline__ int map_gu(int n0) { if (n0 < DFF) return (n0 >> 7) * 256 + (n0 & 127); const int j = n0 - DFF; return (j >> 7) * 256 + 128 + (j & 127); }

__device__ __forceinline__ void p0_prologue(Frame& F, const Args& a) {
    const float* x = (const float*)a.in[0]; const float* mem = (const float*)a.in[1]; const int* positions = (const int*)a.in[2];
    const float* g_mix_pre = (const float*)a.in[3]; const float* w_in = (const float*)a.in[4];
    const float* a_log = (const float*)a.in[6]; const float* dt_bias = (const float*)a.in[7];
    const float* w_out = (const float*)a.in[10]; const float* g_cross_pre = (const float*)a.in[12]; const float* g_mem = (const float*)a.in[13];
    const float* w_cq = (const float*)a.in[14]; const float* w_ckv = (const float*)a.in[15]; const float* w_co = (const float*)a.in[16];
    const float* g_ffn_pre = (const float*)a.in[18]; const float* w_gu = (const float*)a.in[19]; const float* w_down = (const float*)a.in[20];
    bf16* R1 = (bf16*)(F.ws + WS_REG1);
    LAS float* W16s = (LAS float*)(F.lds);
    LAS float* scr = (LAS float*)(F.lds + 65536 + F.wave * 8448);
    const int gw = F.vcu * NWAVES + F.wave, NGW = F.G * NWAVES;
    for (int k = F.tid; k < D; k += NWAVES * 64) { const float gv = g_mix_pre[k]; const float* src = w_in + (size_t)k * INC + 2816;
#pragma unroll
        for (int c = 0; c < 16; ++c) W16s[c * D + k] = src[c] * gv; }
    constexpr int I_IN = 16 * 88, I_KV = 16 * 64, I_SQ = 16 * 32, I_GU = 16 * 176, I_DN = 44 * 32;
    constexpr int NITEMS = I_IN + I_KV + 3 * I_SQ + I_GU + I_DN;
    for (int it = gw; it < NITEMS; it += NGW) {
        int r = it;
        if (r < I_IN) { const int kb = r / 88, nb = r % 88; p0_transpose_item(w_in, INC, g_mix_pre, R1 + (size_t)R1_WIN * D, D, 64 * kb, 32 * nb, map_win(32 * nb), scr, F.lane); continue; } r -= I_IN;
        if (r < I_KV) { const int kb = r / 64, nb = r % 64; p0_transpose_item(w_ckv, 2048, g_mem, R1 + (size_t)R1_WK * D, D, 64 * kb, 32 * nb, 32 * nb, scr, F.lane); continue; } r -= I_KV;
        if (r < I_SQ) { const int kb = r / 32, nb = r % 32; p0_transpose_item(w_out, D, nullptr, (bf16*)(F.ws + WS_WOUT), D, 64 * kb, 32 * nb, 32 * nb, scr, F.lane); continue; } r -= I_SQ;
        if (r < I_SQ) { const int kb = r / 32, nb = r % 32; p0_transpose_item(w_cq, D, g_cross_pre, (bf16*)(F.ws + WS_WCQ), D, 64 * kb, 32 * nb, 32 * nb, scr, F.lane); continue; } r -= I_SQ;
        if (r < I_SQ) { const int kb = r / 32, nb = r % 32; p0_transpose_item(w_co, D, nullptr, (bf16*)(F.ws + WS_WCO), D, 64 * kb, 32 * nb, 32 * nb, scr, F.lane); continue; } r -= I_SQ;
        if (r < I_GU) { const int kb = r / 176, nb = r % 176; p0_transpose_item(w_gu, 2 * DFF, g_ffn_pre, (bf16*)(F.ws + WS_WGU), D, 64 * kb, 32 * nb, map_gu(32 * nb), scr, F.lane); continue; } r -= I_GU;
        { const int kb = r / 32, nb = r % 32; p0_transpose_item(w_down, D, nullptr, (bf16*)(F.ws + WS_WDOWN), DFF, 64 * kb, 32 * nb, 32 * nb, scr, F.lane); }
    }
    __syncthreads();
    float* gbuf = (float*)(F.ws + WS_GB);
    for (int m0 = gw; m0 < M; m0 += 4 * NGW) {
        f32x4 v[4][4]; float rs[4];
#pragma unroll
        for (int r = 0; r < 4; ++r) { const GAS f32x4* xr = (const GAS f32x4*)(x + (size_t)(m0 + r * NGW) * D) + F.lane;
#pragma unroll
            for (int j = 0; j < 4; ++j) v[r][j] = xr[64 * j]; }
#pragma unroll
        for (int r = 0; r < 4; ++r) { float s = 0.f;
#pragma unroll
            for (int j = 0; j < 4; ++j) s += (v[r][j].x * v[r][j].x + v[r][j].y * v[r][j].y) + (v[r][j].z * v[r][j].z + v[r][j].w * v[r][j].w);
            rs[r] = s; }
#pragma unroll
        for (int o = 1; o < 64; o <<= 1) {
#pragma unroll
            for (int r = 0; r < 4; ++r) rs[r] += __shfl_xor(rs[r], o); }
#pragma unroll
        for (int r = 0; r < 4; ++r) { const float rstd = rsqrtf(rs[r] * (1.f / D) + EPS);
            GAS unsigned long long* o8 = (GAS unsigned long long*)(R1 + (size_t)(R1_XN + m0 + r * NGW) * D) + F.lane;
#pragma unroll
            for (int j = 0; j < 4; ++j) { v[r][j] = v[r][j] * rstd; o8[64 * j] = (unsigned long long)pk2(v[r][j].x, v[r][j].y) | ((unsigned long long)pk2(v[r][j].z, v[r][j].w) << 32); } }
        float p[64];
#pragma unroll
        for (int c = 0; c < 16; ++c) { f32x4 w[4];
#pragma unroll
            for (int j = 0; j < 4; ++j) w[j] = *(const LAS f32x4*)(W16s + c * D + 4 * F.lane + 256 * j);
#pragma unroll
            for (int r = 0; r < 4; ++r) { float a = 0.f;
#pragma unroll
                for (int j = 0; j < 4; ++j) a += (v[r][j].x * w[j].x + v[r][j].y * w[j].y) + (v[r][j].z * w[j].z + v[r][j].w * w[j].w);
                p[r * 16 + c] = a; }
            if ((c & 3) == 3) __builtin_amdgcn_sched_barrier(0); }
#pragma unroll
        for (int k = 5; k >= 0; --k) { const int hmask = 1 << k; const bool up = (F.lane & hmask) != 0;
#pragma unroll
            for (int i = 0; i < hmask; ++i) { const float keep = up ? p[i + hmask] : p[i], send = up ? p[i] : p[i + hmask]; p[i] = keep + __shfl_xor(send, hmask); } }
        { const float mine = p[0]; const int r = F.lane >> 4, c = F.lane & 15, m = m0 + r * NGW; const int b = m >> 11, sidx = m & 2047;
            if (c < 8) { const int dir = c >> 2, h = c & 3; const float av = mine + dt_bias[c]; const float sp = av > 20.f ? av : log1pf(expf(av));
                gbuf[((size_t)(dir * 8 + b) * 4 + h) * 2048 + sidx] = -expf(a_log[c]) * sp; }
            else { const int c2 = c - 8, dir = c2 >> 2, h = c2 & 3; gbuf[131072 + ((size_t)(dir * 8 + b) * 4 + h) * 2048 + sidx] = 1.f / (1.f + expf(-mine)); } }
    }
    for (int m = gw; m < MMEM; m += NGW) {
        const GAS f32x4* xr = (const GAS f32x4*)(mem + (size_t)m * D) + F.lane;
        f32x4 v[4]; float s = 0.f;
#pragma unroll
        for (int j = 0; j < 4; ++j) { v[j] = xr[64 * j]; s += (v[j].x * v[j].x + v[j].y * v[j].y) + (v[j].z * v[j].z + v[j].w * v[j].w); }
        const float rstd = rsqrtf(wave_sum(s) * (1.f / D) + EPS);
        GAS unsigned long long* o8 = (GAS unsigned long long*)(R1 + (size_t)(R1_MEMN + m) * D) + F.lane;
#pragma unroll
        for (int j = 0; j < 4; ++j) o8[64 * j] = (unsigned long long)pk2(v[j].x * rstd, v[j].y * rstd) | ((unsigned long long)pk2(v[j].z * rstd, v[j].w * rstd) << 32);
    }
    { float2* rope = (float2*)(F.ws + WS_ROPE); const int gt = F.vcu * (NWAVES * 64) + F.tid, NT = F.G * NWAVES * 64;
      for (int e = gt; e < M * 32; e += NT) { const int tok = e >> 5, d = e & 31; const float pos = (float)positions[tok];
          const float inv = powf(10000.f, -(float)d / 32.f); const float ang = pos * inv;
          const double ar = (double)ang * 0.15915494309189535; const double fr = ar - rint(ar);
          rope[e] = make_float2(__builtin_amdgcn_cosf((float)fr), __builtin_amdgcn_sinf((float)fr)); } }
}

struct SchedP1 {
    int G, c;
    __device__ bool next(int i, pg8::Unit& u) const {
        const int L = i * G + c; if (L >= 768) return false;
        if (L < 704) { const int nwg = 704, nN = 11, nM = 64; int wgid = L; { const int q = nwg / 8, xcd = wgid % 8, off = wgid / 8; wgid = xcd * q + off; }
            const int nig = 8 * nN, gid = wgid / nig, fm = gid * 8; u.pm = fm + ((wgid % nig) % 8); u.pn = T_WIN + (wgid % nig) / 8; (void)nM; return true; }
        const int idx = L - 704;
        if (idx < 32) { u.pm = T_MEMN + (idx >> 2); u.pn = T_WK + (idx & 3); } else { const int j = idx - 32; u.pm = T_WV + (j >> 3); u.pn = T_MEMN + (j & 7); }
        return true;
    }
    __device__ __forceinline__ void a_ready(const pg8::Unit&) const {}
    __device__ __forceinline__ void done(const pg8::Unit&) const {}
};
typedef pg8::f32x4 (AccT)[2][2][4][2];
__device__ __forceinline__ void store_tile(const pg8::f32x4 (&acc)[2][2][4][2], bf16* base, int ldc, int row0, int col0, float sc) {
#pragma unroll
    for (int ai = 0; ai < 2; ++ai)
#pragma unroll
        for (int m = 0; m < 4; ++m) { bf16* rowp = base + (size_t)(row0 + ai * 128 + m * 16) * ldc + col0;
#pragma unroll
            for (int bj = 0; bj < 2; ++bj) { const pg8::f32x4 v0 = acc[ai][bj][m][0] * sc, v1 = acc[ai][bj][m][1] * sc; pg8::u32x4 w;
                w.x = pg8::cvt_pk_bf16(v0[0], v0[1]); w.y = pg8::cvt_pk_bf16(v0[2], v0[3]); w.z = pg8::cvt_pk_bf16(v1[0], v1[1]); w.w = pg8::cvt_pk_bf16(v1[2], v1[3]);
                *(pg8::u32x4*)(rowp + bj * 128) = w; } }
}
__device__ __forceinline__ void store_rope(const pg8::f32x4 (&acc)[2][2][4][2], bf16* base, int ldc, int row0, int c1, int fq, const float2* rope, float sc) {
#pragma unroll
    for (int ai = 0; ai < 2; ++ai)
#pragma unroll
        for (int m = 0; m < 4; ++m) { const int row = row0 + ai * 128 + m * 16; const float4* rp = (const float4*)(rope + (size_t)row * 32 + 8 * fq);
            const float4 r0 = rp[0], r1 = rp[1], r2 = rp[2], r3 = rp[3];
            const float cs[8] = {r0.x, r0.z, r1.x, r1.z, r2.x, r2.z, r3.x, r3.z}, sn[8] = {r0.y, r0.w, r1.y, r1.w, r2.y, r2.w, r3.y, r3.w};
            float y1[8], y2[8];
#pragma unroll
            for (int n = 0; n < 2; ++n)
#pragma unroll
                for (int e = 0; e < 4; ++e) { const float x1 = acc[ai][0][m][n][e], x2 = acc[ai][1][m][n][e]; const int d = 4 * n + e;
                    y1[d] = (x1 * cs[d] - x2 * sn[d]) * sc; y2[d] = (x2 * cs[d] + x1 * sn[d]) * sc; }
            bf16* rowp = base + (size_t)row * ldc + c1 + 8 * fq; pg8::u32x4 w;
            w.x = pg8::cvt_pk_bf16(y1[0], y1[1]); w.y = pg8::cvt_pk_bf16(y1[2], y1[3]); w.z = pg8::cvt_pk_bf16(y1[4], y1[5]); w.w = pg8::cvt_pk_bf16(y1[6], y1[7]); *(pg8::u32x4*)(rowp) = w;
            w.x = pg8::cvt_pk_bf16(y2[0], y2[1]); w.y = pg8::cvt_pk_bf16(y2[2], y2[3]); w.z = pg8::cvt_pk_bf16(y2[4], y2[5]); w.w = pg8::cvt_pk_bf16(y2[6], y2[7]); *(pg8::u32x4*)(rowp + 32) = w; }
}
struct EpiP1 {
    static constexpr bool PERM = true, AFTER_DRAIN = false;
    unsigned char* ws;
    __device__ __forceinline__ void operator()(const pg8::f32x4 (&acc)[2][2][4][2], const pg8::Unit& u, int wr, int wc, int fr, int fq) const {
        const int rloc = wr * 64 + fr, cloc = wc * 32 + 8 * fq;
        if (u.pm >= T_WV) { store_tile(acc, (bf16*)(ws + WS_VCT), 2048, (u.pm - T_WV) * 256 + rloc, (u.pn - T_MEMN) * 256 + cloc, 1.f); return; }
        if (u.pm >= T_MEMN) { store_tile(acc, (bf16*)(ws + WS_KC), 1024, (u.pm - T_MEMN) * 256 + rloc, (u.pn - T_WK) * 256 + cloc, 1.f); return; }
        const int pl = u.pn - T_WIN, row0 = u.pm * 256 + rloc;
        if (pl >= 9) { store_tile(acc, (bf16*)(ws + WS_DGATE), 512, row0, (pl - 9) * 256 + cloc, 1.f); return; }
        if (pl >= 3) { store_tile(acc, (bf16*)(ws + WS_DQKV), 1536, row0, (pl - 3) * 256 + cloc, 1.f); return; }
        const float2* rope = (const float2*)(ws + WS_ROPE);
        if (pl < 2) { store_rope(acc, (bf16*)(ws + WS_QA), 512, row0, (pl * 4 + wc) * 64, fq, rope, QSCALE_A); return; }
        if (wc < 2) { store_rope(acc, (bf16*)(ws + WS_KA), 128, row0, wc * 64, fq, rope, 1.f); return; }
        bf16* base = (bf16*)(ws + WS_VA);
#pragma unroll
        for (int ai = 0; ai < 2; ++ai)
#pragma unroll
            for (int m = 0; m < 4; ++m) { bf16* rowp = base + (size_t)(row0 + ai * 128 + m * 16) * 128 + (wc - 2) * 32 + 8 * fq;
#pragma unroll
                for (int bj = 0; bj < 2; ++bj) { const pg8::f32x4 v0 = acc[ai][bj][m][0], v1 = acc[ai][bj][m][1]; pg8::u32x4 w;
                    w.x = pg8::cvt_pk_bf16(v0[0], v0[1]); w.y = pg8::cvt_pk_bf16(v0[2], v0[3]); w.z = pg8::cvt_pk_bf16(v1[0], v1[1]); w.w = pg8::cvt_pk_bf16(v1[2], v1[3]);
                    *(pg8::u32x4*)(rowp + bj * 64) = w; } }
    }
};
struct EpiPlain {
    static constexpr bool PERM = true, AFTER_DRAIN = false;
    bf16* O; int ldc; float scale;
    __device__ __forceinline__ void operator()(const pg8::f32x4 (&acc)[2][2][4][2], const pg8::Unit& u, int wr, int wc, int fr, int fq) const {
        store_tile(acc, O, ldc, u.pm * 256 + wr * 64 + fr, u.pn * 256 + wc * 32 + 8 * fq, scale);
    }
};
struct EpiRowScale {
    static constexpr bool PERM = true, AFTER_DRAIN = false;
    bf16* O; int ldc; float scale; const float* rs;
    __device__ __forceinline__ void operator()(const pg8::f32x4 (&acc)[2][2][4][2], const pg8::Unit& u, int wr, int wc, int fr, int fq) const {
        const int row0 = u.pm * 256 + wr * 64 + fr, col0 = u.pn * 256 + wc * 32 + 8 * fq;
#pragma unroll
        for (int ai = 0; ai < 2; ++ai)
#pragma unroll
            for (int m = 0; m < 4; ++m) { const int row = row0 + ai * 128 + m * 16; const float sc = rs[row] * scale; bf16* rowp = O + (size_t)row * ldc + col0;
#pragma unroll
                for (int bj = 0; bj < 2; ++bj) { const pg8::f32x4 v0 = acc[ai][bj][m][0] * sc, v1 = acc[ai][bj][m][1] * sc; pg8::u32x4 w;
                    w.x = pg8::cvt_pk_bf16(v0[0], v0[1]); w.y = pg8::cvt_pk_bf16(v0[2], v0[3]); w.z = pg8::cvt_pk_bf16(v1[0], v1[1]); w.w = pg8::cvt_pk_bf16(v1[2], v1[3]);
                    *(pg8::u32x4*)(rowp + bj * 128) = w; } }
    }
};
struct EpiSwiglu {
    static constexpr bool PERM = true, AFTER_DRAIN = false;
    bf16* O; const float* rs;
    __device__ __forceinline__ void operator()(const pg8::f32x4 (&acc)[2][2][4][2], const pg8::Unit& u, int wr, int wc, int fr, int fq) const {
        const int row0 = u.pm * 256 + wr * 64 + fr, col0 = u.pn * 128 + wc * 32 + 8 * fq;
#pragma unroll
        for (int ai = 0; ai < 2; ++ai)
#pragma unroll
            for (int m = 0; m < 4; ++m) { float y[8]; const float sc = rs[row0 + ai * 128 + m * 16];
#pragma unroll
                for (int n = 0; n < 2; ++n)
#pragma unroll
                    for (int e = 0; e < 4; ++e) { const float gt = acc[ai][0][m][n][e] * sc, up = acc[ai][1][m][n][e] * sc; y[4 * n + e] = gt * __builtin_amdgcn_rcpf(1.f + __builtin_amdgcn_exp2f(-LOG2E * gt)) * up; }
                pg8::u32x4 w; w.x = pg8::cvt_pk_bf16(y[0], y[1]); w.y = pg8::cvt_pk_bf16(y[2], y[3]); w.z = pg8::cvt_pk_bf16(y[4], y[5]); w.w = pg8::cvt_pk_bf16(y[6], y[7]);
                *(pg8::u32x4*)(O + (size_t)(row0 + ai * 128 + m * 16) * DFF + col0) = w; }
    }
};
template <int MODE>
__device__ __forceinline__ void row_pass(Frame& F, const void* base, const bf16* y, const float* g, bf16* xb, float* rs, float* fout) {
    const int gw = F.vcu * NWAVES + F.wave, NGW = F.G * NWAVES;
    f32x4 gg[4];
#pragma unroll
    for (int j = 0; j < 4; ++j) gg[j] = ((const GAS f32x4*)g)[F.lane + 64 * j];
    for (int m0 = gw; m0 < M; m0 += 2 * NGW) {
        f32x4 yv[2][4], bv[2][4]; float s[2];
#pragma unroll
        for (int r = 0; r < 2; ++r) { const int m = m0 + r * NGW; const GAS v2u* yr = (const GAS v2u*)(y + (size_t)m * D) + F.lane;
#pragma unroll
            for (int j = 0; j < 4; ++j) { const v2u w = yr[64 * j]; yv[r][j] = (f32x4){bflo(w.x), bfhi(w.x), bflo(w.y), bfhi(w.y)};
                if (MODE == 0) bv[r][j] = ((const GAS f32x4*)((const float*)base + (size_t)m * D))[F.lane + 64 * j];
                else { const v2u b2 = ((const GAS v2u*)((const bf16*)base + (size_t)m * D))[F.lane + 64 * j]; bv[r][j] = (f32x4){bflo(b2.x), bfhi(b2.x), bflo(b2.y), bfhi(b2.y)}; } } }
#pragma unroll
        for (int r = 0; r < 2; ++r) { float a = 0.f;
#pragma unroll
            for (int j = 0; j < 4; ++j) a += (yv[r][j].x * yv[r][j].x + yv[r][j].y * yv[r][j].y) + (yv[r][j].z * yv[r][j].z + yv[r][j].w * yv[r][j].w);
            s[r] = a; }
#pragma unroll
        for (int o = 1; o < 64; o <<= 1) { s[0] += __shfl_xor(s[0], o); s[1] += __shfl_xor(s[1], o); }
        float s2[2];
#pragma unroll
        for (int r = 0; r < 2; ++r) { const float rr = rsqrtf(s[r] * (1.f / D) + EPS); float a = 0.f;
#pragma unroll
            for (int j = 0; j < 4; ++j) { bv[r][j] = bv[r][j] + yv[r][j] * rr * gg[j]; a += (bv[r][j].x * bv[r][j].x + bv[r][j].y * bv[r][j].y) + (bv[r][j].z * bv[r][j].z + bv[r][j].w * bv[r][j].w); }
            s2[r] = a; }
        if (MODE == 2) {
#pragma unroll
            for (int r = 0; r < 2; ++r) { GAS f32x4* orow = (GAS f32x4*)(fout + (size_t)(m0 + r * NGW) * D) + F.lane;
#pragma unroll
                for (int j = 0; j < 4; ++j) orow[64 * j] = bv[r][j]; }
        } else {
#pragma unroll
            for (int o = 1; o < 64; o <<= 1) { s2[0] += __shfl_xor(s2[0], o); s2[1] += __shfl_xor(s2[1], o); }
#pragma unroll
            for (int r = 0; r < 2; ++r) { const int m = m0 + r * NGW; GAS v2u* o8 = (GAS v2u*)(xb + (size_t)m * D) + F.lane;
#pragma unroll
                for (int j = 0; j < 4; ++j) o8[64 * j] = (v2u){pk2(bv[r][j].x, bv[r][j].y), pk2(bv[r][j].z, bv[r][j].w)};
                if (F.lane == 0) rs[m] = rsqrtf(s2[r] * (1.f / D) + EPS); }
        }
    }
}
__device__ __forceinline__ void dn_combine(Frame& F, const float* g_out) {
    const int gw = F.vcu * NWAVES + F.wave, NGW = F.G * NWAVES;
    const bf16* ofb = (const bf16*)(F.ws + WS_OFB); const bf16* gate = (const bf16*)(F.ws + WS_DGATE); bf16* mix = (bf16*)(F.ws + WS_MIX);
    float go[8];
#pragma unroll
    for (int e = 0; e < 8; ++e) go[e] = g_out[((8 * F.lane) & 127) + e];
    for (int m = gw; m < M; m += NGW) {
        const v4u a = *(const GAS v4u*)(ofb + (size_t)m * 512 + 8 * F.lane), b = *(const GAS v4u*)(ofb + ((size_t)M + m) * 512 + 8 * F.lane), gt = *(const GAS v4u*)(gate + (size_t)m * 512 + 8 * F.lane);
        float o[8], gv[8];
        o[0] = bflo(a.x) + bflo(b.x); o[1] = bfhi(a.x) + bfhi(b.x); o[2] = bflo(a.y) + bflo(b.y); o[3] = bfhi(a.y) + bfhi(b.y);
        o[4] = bflo(a.z) + bflo(b.z); o[5] = bfhi(a.z) + bfhi(b.z); o[6] = bflo(a.w) + bflo(b.w); o[7] = bfhi(a.w) + bfhi(b.w);
        gv[0] = bflo(gt.x); gv[1] = bfhi(gt.x); gv[2] = bflo(gt.y); gv[3] = bfhi(gt.y); gv[4] = bflo(gt.z); gv[5] = bfhi(gt.z); gv[6] = bflo(gt.w); gv[7] = bfhi(gt.w);
        float s = 0.f;
#pragma unroll
        for (int e = 0; e < 8; ++e) s += o[e] * o[e];
        s += __shfl_xor(s, 1); s += __shfl_xor(s, 2); s += __shfl_xor(s, 4); s += __shfl_xor(s, 8);
        const float r = rsqrtf(s * (1.f / 128.f) + EPS);
#pragma unroll
        for (int e = 0; e < 8; ++e) o[e] = o[e] * r * go[e] * silu_f(gv[e]);
        v4u w; w.x = pk2(o[0], o[1]); w.y = pk2(o[2], o[3]); w.z = pk2(o[4], o[5]); w.w = pk2(o[6], o[7]);
        *(GAS v4u*)(mix + (size_t)m * D + 512 + 8 * F.lane) = w;
    }
}
typedef float f32x16 __attribute__((ext_vector_type(16)));
typedef float f32x2_t __attribute__((ext_vector_type(2)));
typedef __bf16 bf16x2_t __attribute__((ext_vector_type(2)));
__device__ __forceinline__ unsigned cvtpk(float lo, float hi) { f32x2_t v = {lo, hi}; bf16x2_t b = __builtin_convertvector(v, bf16x2_t); return __builtin_bit_cast(unsigned, b); }
__device__ __forceinline__ int crow(int r, int hi) { return (r & 3) + 8 * (r >> 2) + 4 * hi; }
#define MFMA32(a, b, c) __builtin_amdgcn_mfma_f32_32x32x16_bf16((a), (b), (c), 0, 0, 0)
__device__ __forceinline__ bf16x8 pack8(const f32x16& x, int s) {
    v4u p; p.x = cvtpk(x[8 * s], x[8 * s + 1]); p.y = cvtpk(x[8 * s + 2], x[8 * s + 3]); p.z = cvtpk(x[8 * s + 4], x[8 * s + 5]); p.w = cvtpk(x[8 * s + 6], x[8 * s + 7]);
    return __builtin_bit_cast(bf16x8, p);
}
__device__ __forceinline__ float max16(const f32x16& x) {
    float a = fmaxf(fmaxf(x[0], x[1]), fmaxf(x[2], x[3])), b = fmaxf(fmaxf(x[4], x[5]), fmaxf(x[6], x[7]));
    float c = fmaxf(fmaxf(x[8], x[9]), fmaxf(x[10], x[11])), d = fmaxf(fmaxf(x[12], x[13]), fmaxf(x[14], x[15]));
    return fmaxf(fmaxf(a, b), fmaxf(c, d));
}
__device__ __forceinline__ int perm16(int k) { return 8 * ((k >> 2) & 1) + ((k >> 3) << 2) + (k & 3); }

__device__ __forceinline__ void cross_attn_phase(Frame& F) {
    const bf16* QC = (const bf16*)(F.ws + WS_QC); const bf16* KC = (const bf16*)(F.ws + WS_KC); const bf16* VCT = (const bf16*)(F.ws + WS_VCT); bf16* OC = (bf16*)(F.ws + WS_OC);
    LAS unsigned char* L = F.lds;
    LAS float* lsc = (LAS float*)(F.lds + 131072) + F.wave * 32;
    const int lane = F.lane, r32 = lane & 31, hi = lane >> 5, sw = r32 & 15;
    for (int u = F.vcu; u < 256; u += F.G) {
        const int bh = u >> 3, qb = u & 7, b = bh >> 2, hd = bh & 3;
        __syncthreads();
#pragma unroll 4
        for (int i = 0; i < 16; ++i) { const int it = F.tid + 512 * i, key = it >> 5, c = it & 31;
            const v4u v = *(const GAS v4u*)(KC + (size_t)(b * 256 + key) * 1024 + hd * 256 + 8 * c);
            *(LAS v4u*)(L + key * 512 + ((c ^ (key & 15)) << 4)) = v; }
        __syncthreads();
        const size_t tok0 = (size_t)b * 2048 + qb * 256 + F.wave * 32;
        const bf16* qrow = QC + (tok0 + r32) * 1024 + hd * 256 + 8 * hi;
        f32x16 acc[8];
#pragma unroll
        for (int kt = 0; kt < 8; ++kt)
#pragma unroll
            for (int r = 0; r < 16; ++r) acc[kt][r] = 0.f;
#pragma unroll 2
        for (int ks = 0; ks < 16; ++ks) {
            const bf16x8 qf = *(const GAS bf16x8*)(qrow + 16 * ks);
            const int coff = ((2 * ks + hi) ^ sw) << 4;
#pragma unroll
            for (int kt = 0; kt < 8; ++kt) { const bf16x8 kf = *(const LAS bf16x8*)(L + (32 * kt + r32) * 512 + coff); acc[kt] = MFMA32(kf, qf, acc[kt]); }
        }
        float m = max16(acc[0]);
#pragma unroll
        for (int kt = 1; kt < 8; ++kt) m = fmaxf(m, max16(acc[kt]));
        m = fmaxf(m, __shfl_xor(m, 32));
        float l = 0.f;
#pragma unroll
        for (int kt = 0; kt < 8; ++kt)
#pragma unroll
            for (int r = 0; r < 16; ++r) { const float p = __builtin_amdgcn_exp2f(acc[kt][r] - m); acc[kt][r] = p; l += p; }
        l += __shfl_xor(l, 32);
        bf16x8 pa[8][2];
#pragma unroll
        for (int kt = 0; kt < 8; ++kt) { pa[kt][0] = pack8(acc[kt], 0); pa[kt][1] = pack8(acc[kt], 1); }
        if (hi == 0) lsc[r32] = l;
        __syncthreads();
#pragma unroll 4
        for (int i = 0; i < 8; ++i) { const int it = F.tid + 512 * i, d = it >> 4, g = it & 15;
            const bf16* src = VCT + (size_t)(hd * 256 + d) * 2048 + b * 256 + 16 * g;
            const v4u A = *(const GAS v4u*)(src), B = *(const GAS v4u*)(src + 8);
            *(LAS v4u*)(L + d * 512 + (((2 * g) ^ (d & 15)) << 4)) = (v4u){A.x, A.y, B.x, B.y};
            *(LAS v4u*)(L + d * 512 + (((2 * g + 1) ^ (d & 15)) << 4)) = (v4u){A.z, A.w, B.z, B.w}; }
        __syncthreads();
        float rl[16];
#pragma unroll
        for (int r = 0; r < 16; ++r) rl[r] = __builtin_amdgcn_rcpf(lsc[crow(r, hi)]);
#pragma unroll 1
        for (int dt = 0; dt < 8; ++dt) {
            f32x16 o;
#pragma unroll
            for (int r = 0; r < 16; ++r) o[r] = 0.f;
            const LAS unsigned char* vrow = L + (32 * dt + r32) * 512;
#pragma unroll
            for (int kt = 0; kt < 8; ++kt)
#pragma unroll
                for (int s = 0; s < 2; ++s) { const bf16x8 vf = *(const LAS bf16x8*)(vrow + (((4 * kt + 2 * s + hi) ^ sw) << 4)); o = MFMA32(pa[kt][s], vf, o); }
            bf16* op = OC + tok0 * 1024 + hd * 256 + 32 * dt + r32;
#pragma unroll
            for (int r = 0; r < 16; ++r) op[(size_t)crow(r, hi) * 1024] = (bf16)f2bf(o[r] * rl[r]);
        }
    }
}

__device__ __forceinline__ void window_attn_phase(Frame& F, const float* sink) {
    const bf16* QA = (const bf16*)(F.ws + WS_QA); const bf16* KA = (const bf16*)(F.ws + WS_KA); const bf16* VA = (const bf16*)(F.ws + WS_VA); bf16* MIX = (bf16*)(F.ws + WS_MIX);
    LAS unsigned char* LK = F.lds;
    LAS unsigned char* LV = F.lds + 49152;
    LAS float* lsc = (LAS float*)(F.lds + 98304) + F.wave * 32;
    const int lane = F.lane, r32 = lane & 31, hi = lane >> 5;
    for (int u = F.vcu; u < 256; u += F.G) {
        const int b = u >> 5, kvh = (u >> 4) & 1, n = u & 15;
        const int tokb = b * 2048 + 128 * (n - 1);
        __syncthreads();
#pragma unroll 2
        for (int i = 0; i < 6; ++i) { const int it = F.tid + 512 * i, key = it >> 3, c = it & 7; const int t = 128 * (n - 1) + key;
            v4u kv = (v4u){0u, 0u, 0u, 0u}, vv = kv;
            if (t >= 0 && t < 2048) { kv = *(const GAS v4u*)(KA + (size_t)(tokb + key) * 128 + kvh * 64 + 8 * c); vv = *(const GAS v4u*)(VA + (size_t)(tokb + key) * 128 + kvh * 64 + 8 * c); }
            *(LAS v4u*)(LK + key * 128 + ((c ^ ((key >> 1) & 7)) << 4)) = kv;
            const int pos = (key & ~15) | perm16(key & 15);
            const unsigned w[4] = {vv.x, vv.y, vv.z, vv.w};
#pragma unroll
            for (int e = 0; e < 8; ++e) { const int d = 8 * c + e; const unsigned short val = (e & 1) ? (unsigned short)(w[e >> 1] >> 16) : (unsigned short)(w[e >> 1] & 0xffffu);
                *(LAS unsigned short*)(LV + d * 768 + (((pos >> 3) ^ (d & 15)) << 4) + (pos & 7) * 2) = val; } }
        __syncthreads();
        const int g = F.wave >> 1, th = F.wave & 1, hq = kvh * 4 + g;
        const float sinkl = sink[hq] * LOG2E;
#pragma unroll 1
        for (int qt = 0; qt < 2; ++qt) {
            const int q0 = 64 * th + 32 * qt, qq = q0 + r32;
            const size_t tokq = (size_t)b * 2048 + 128 * n + q0;
            bf16x8 qf[4];
#pragma unroll
            for (int ks = 0; ks < 4; ++ks) qf[ks] = *(const GAS bf16x8*)(QA + (tokq + r32) * 512 + hq * 64 + 16 * ks + 8 * hi);
            const int kt_lo = q0 >> 5, kt_hi = (287 + q0) >> 5;
            const int klo = (n == 0) ? 128 : 0, khi = (n == 15) ? 255 : 383;
            float m = -INFINITY;
#pragma unroll 1
            for (int kt = kt_lo; kt <= kt_hi; ++kt) {
                f32x16 s;
#pragma unroll
                for (int r = 0; r < 16; ++r) s[r] = 0.f;
                const int key = 32 * kt + r32;
#pragma unroll
                for (int ks = 0; ks < 4; ++ks) { const bf16x8 kf = *(const LAS bf16x8*)(LK + key * 128 + (((2 * ks + hi) ^ ((key >> 1) & 7)) << 4)); s = MFMA32(kf, qf[ks], s); }
#pragma unroll
                for (int r = 0; r < 16; ++r) { const int kk = 32 * kt + crow(r, hi); const bool ok = (kk >= qq) && (kk <= 256 + qq) && (kk >= klo) && (kk <= khi); m = fmaxf(m, ok ? s[r] : -INFINITY); }
            }
            m = fmaxf(m, __shfl_xor(m, 32)); m = fmaxf(m, sinkl);
            float l = 0.f; f32x16 o0, o1;
#pragma unroll
            for (int r = 0; r < 16; ++r) { o0[r] = 0.f; o1[r] = 0.f; }
#pragma unroll 1
            for (int kt = kt_lo; kt <= kt_hi; ++kt) {
                f32x16 s;
#pragma unroll
                for (int r = 0; r < 16; ++r) s[r] = 0.f;
                const int key = 32 * kt + r32;
#pragma unroll
                for (int ks = 0; ks < 4; ++ks) { const bf16x8 kf = *(const LAS bf16x8*)(LK + key * 128 + (((2 * ks + hi) ^ ((key >> 1) & 7)) << 4)); s = MFMA32(kf, qf[ks], s); }
#pragma unroll
                for (int r = 0; r < 16; ++r) { const int kk = 32 * kt + crow(r, hi); const bool ok = (kk >= qq) && (kk <= 256 + qq) && (kk >= klo) && (kk <= khi);
                    const float p = ok ? __builtin_amdgcn_exp2f(s[r] - m) : 0.f; s[r] = p; l += p; }
#pragma unroll
                for (int ss = 0; ss < 2; ++ss) { const bf16x8 pa = pack8(s, ss); const int ch = 4 * kt + 2 * ss + hi;
                    const bf16x8 v0 = *(const LAS bf16x8*)(LV + r32 * 768 + ((ch ^ (r32 & 15)) << 4)), v1 = *(const LAS bf16x8*)(LV + (32 + r32) * 768 + ((ch ^ (r32 & 15)) << 4));
                    o0 = MFMA32(pa, v0, o0); o1 = MFMA32(pa, v1, o1); }
            }
            l += __shfl_xor(l, 32); l += __builtin_amdgcn_exp2f(sinkl - m);
            if (hi == 0) lsc[r32] = l;
            bf16* op = MIX + tokq * 1024 + hq * 64 + r32;
#pragma unroll
            for (int r = 0; r < 16; ++r) { const float rl = __builtin_amdgcn_rcpf(lsc[crow(r, hi)]); op[(size_t)crow(r, hi) * 1024] = (bf16)f2bf(o0[r] * rl); op[(size_t)crow(r, hi) * 1024 + 32] = (bf16)f2bf(o1[r] * rl); }
        }
    }
}
constexpr size_t PS_BYTES = 32768, PD_BYTES = 40960; constexpr int SC_FLOATS = 320;
constexpr size_t WS_PD = 157 * MiB;
constexpr size_t OUT_PS = 0, OUT_SC = 32 * MiB;
constexpr size_t WS_LM0 = 237 * MiB, OUT_LM1 = 36 * MiB;
constexpr size_t OUT_VTF = 52 * MiB, WS_VTF_HI = 25 * MiB;
__device__ __forceinline__ int krow(int s, int h, int j) { return 16 * s + 8 * (j >> 2) + 4 * h + (j & 3); }
#define BAR_LDS() asm volatile("s_waitcnt lgkmcnt(0)\n\ts_barrier" ::: "memory")

constexpr int DL_QS = 0, DL_KS = 16384, DL_PART = 32768, DL_SM = 40960;
__device__ __forceinline__ int img256(int row, int chunk) { return row * 256 + ((chunk ^ (row & 15)) << 4); }
__device__ __forceinline__ int img128(int row, int chunk) { return row * 128 + ((chunk ^ ((row >> 1) & 7)) << 4); }
__device__ __forceinline__ unsigned char* vtf_ptr(Frame& F, int bhc) { return bhc < 768 ? (unsigned char*)F.out + OUT_VTF + (size_t)bhc * 16384 : F.ws + WS_VTF_HI + (size_t)(bhc - 768) * 16384; }
__device__ __forceinline__ float* lm_ptr(Frame& F, int bhc, int d) { return (float*)(d ? (unsigned char*)F.out + OUT_LM1 : F.ws + WS_LM0) + (size_t)bhc * 4096; }

__device__ __forceinline__ void dn_prep_phase(Frame& F, const float* conv_w, int mode = 3) {
    const bf16* DQ = (const bf16*)(F.ws + WS_DQKV); const float* gb = (const float*)(F.ws + WS_GB);
    LAS unsigned char* L = F.lds;
    LAS float* RQ = (LAS float*)(L + DL_SM); LAS float* RK = RQ + 64; LAS float* BETA = RQ + 128; LAS float* GCN = RQ + 256; LAS float* GLs = RQ + 384;
    LAS float* PART = (LAS float*)(L + DL_PART);
    const int tid0 = F.tid, lane0 = F.lane, wave = F.wave;
    for (int u = F.vcu; u < ((mode & 1) ? 1024 : 0); u += F.G) {
        int tid = tid0, lane = lane0; asm volatile("" : "+v"(tid), "+v"(lane));
        const int r32 = lane & 31, hi = lane >> 5;
        const int c = u & 31, h = (u >> 5) & 3, b = u >> 7, bhc = u;
        unsigned char* PS = (unsigned char*)F.out + OUT_PS + (size_t)bhc * PS_BYTES;
        __syncthreads();
        if (wave < 6) { const int cg = tid % 48, tg = tid / 48, kind = cg >> 4, c8 = (cg & 15) * 8, col = kind * 512 + h * 128 + c8, t0 = 8 * tg;
            v4u xr[12]; f32x4 wv[10];
#pragma unroll
            for (int j = 0; j < 12; ++j) { const int tt = 64 * c + t0 + j - 2; xr[j] = (v4u){0u, 0u, 0u, 0u}; if (tt >= 0 && tt < 2048) xr[j] = *(const GAS v4u*)(DQ + ((size_t)b * 2048 + tt) * 1536 + col); }
#pragma unroll
            for (int w = 0; w < 5; ++w) { wv[2 * w] = *(const GAS f32x4*)(conv_w + w * 1536 + col); wv[2 * w + 1] = *(const GAS f32x4*)(conv_w + w * 1536 + col + 4); }
            float o[8][8];
#pragma unroll
            for (int j = 0; j < 8; ++j) { float acc[8];
#pragma unroll
                for (int e = 0; e < 8; ++e) acc[e] = 0.f;
#pragma unroll
                for (int w = 0; w < 5; ++w) { const v4u x = xr[j + w]; const f32x4 w0 = wv[2 * w], w1 = wv[2 * w + 1];
                    acc[0] += bflo(x.x) * w0.x; acc[1] += bfhi(x.x) * w0.y; acc[2] += bflo(x.y) * w0.z; acc[3] += bfhi(x.y) * w0.w;
                    acc[4] += bflo(x.z) * w1.x; acc[5] += bfhi(x.z) * w1.y; acc[6] += bflo(x.w) * w1.z; acc[7] += bfhi(x.w) * w1.w; }
                float ss = 0.f;
#pragma unroll
                for (int e = 0; e < 8; ++e) { const float a = acc[e] * __builtin_amdgcn_rcpf(1.f + __expf(-acc[e])); o[j][e] = a; ss += a * a; }
                if (kind < 2) { PART[(t0 + j) * 32 + cg] = ss; v4u pk; pk.x = pk2(o[j][0], o[j][1]); pk.y = pk2(o[j][2], o[j][3]); pk.z = pk2(o[j][4], o[j][5]); pk.w = pk2(o[j][6], o[j][7]);
                    *(LAS v4u*)(L + (kind ? DL_KS : DL_QS) + img256(t0 + j, cg & 15)) = pk;
                    if (kind == 0) {
                        const int t = t0 + j, w = c8 >> 5, sst = (c8 >> 4) & 1, jq = (c8 >> 3) & 1; unsigned char* q0 = PS + ((size_t)(((w * 2 + (t >> 5)) * 2 + sst) * 64 + (t & 31))) * 16 + 8 * jq;
                        *(GAS v2u*)(q0) = (v2u){pk.x, pk.y}; *(GAS v2u*)(q0 + 32 * 16) = (v2u){pk.z, pk.w}; } } }
            if (kind >= 1) {
                unsigned char* T = (kind == 1) ? PS + 16384 : vtf_ptr(F, bhc);
#pragma unroll
                for (int e = 0; e < 8; ++e) { const int ch = c8 + e; v4u pk; pk.x = pk2(o[0][e], o[1][e]); pk.y = pk2(o[2][e], o[3][e]); pk.z = pk2(o[4][e], o[5][e]); pk.w = pk2(o[6][e], o[7][e]);
                    *(GAS v4u*)(T + ((size_t)(((ch >> 5) * 4 + (tg >> 1)) * 64 + (ch & 31) + 32 * (tg & 1))) * 16) = pk; } }
        } else { const int d = wave - 6, t = lane; const size_t o = ((size_t)(d * 8 + b) * 4 + h) * 2048 + 64 * c + t;
            float g = gb[o]; BETA[d * 64 + t] = gb[131072 + o];
            if (d == 0) { for (int k = 1; k < 64; k <<= 1) { const float v = __shfl_up(g, k); if (t >= k) g += v; } }
            else { for (int k = 1; k < 64; k <<= 1) { const float v = __shfl_down(g, k); if (t + k < 64) g += v; } }
            GCN[d * 64 + t] = g; if ((d == 0 && t == 63) || (d == 1 && t == 0)) GLs[d] = g; }
        __syncthreads();
        if (tid < 128) { const int t = tid & 63, which = tid >> 6; float s = 0.f;
#pragma unroll
            for (int k = 0; k < 16; ++k) s += PART[t * 32 + which * 16 + k];
            if (which == 0) RQ[t] = rsqrtf(s + EPS) * 0.08838834764831845f; else RK[t] = rsqrtf(s + EPS); }
        __syncthreads();
        { const int at = (wave >> 1) & 1, bt = wave & 1; f32x16 acc;
#pragma unroll
          for (int r = 0; r < 16; ++r) acc[r] = 0.f;
          const int rowA = 32 * at + r32, rowB = 32 * bt + r32; const int offB = (wave < 4) ? DL_KS : DL_QS;
#pragma unroll
          for (int ks = 0; ks < 8; ++ks) { const bf16x8 af = *(const LAS bf16x8*)(L + DL_KS + img256(rowA, 2 * ks + hi)), bf = *(const LAS bf16x8*)(L + offB + img256(rowB, 2 * ks + hi)); acc = MFMA32(af, bf, acc); }
          const int cc = 32 * bt + r32;
          if (wave < 4) {
#pragma unroll
              for (int d = 0; d < 2; ++d) { const float rkc = RK[cc], gcc = GCN[d * 64 + cc]; float* LM = lm_ptr(F, bhc, d);
#pragma unroll
                  for (int r = 0; r < 16; ++r) { const int a = 32 * at + crow(r, hi); const bool ok = d ? (cc > a) : (cc < a);
                      const float ga = GCN[d * 64 + a], ba = BETA[d * 64 + a], rka = RK[a];
                      const float e = __expf(fminf(ga - gcc, 0.f)); float v = ba * rka * rkc * acc[r] * e; v = ok ? v : 0.f;
                      LM[(d ? 63 - a : a) * 64 + (d ? 63 - cc : cc)] = v; } }
          } else {
#pragma unroll
              for (int d = 0; d < 2; ++d) { const float rqt = RQ[cc], gct = GCN[d * 64 + cc]; unsigned char* QKL = F.ws + WS_PD + (size_t)(bhc * 2 + d) * PD_BYTES + 32768;
#pragma unroll
                  for (int g = 0; g < 4; ++g) { float v[4];
#pragma unroll
                      for (int e = 0; e < 4; ++e) { const int s = 32 * at + 8 * g + 4 * hi + e; const bool ok = d ? (s >= cc) : (s <= cc);
                          const float gs = GCN[d * 64 + s], rks = RK[s];
                          const float ex = __expf(fminf(gct - gs, 0.f)); const float vv = rqt * rks * acc[4 * g + e] * ex; v[e] = ok ? vv : 0.f; }
                      const int ksq = 2 * at + (g >> 1), lanep = r32 + 32 * (g & 1);
                      v2u w; w.x = pk2(v[0], v[1]); w.y = pk2(v[2], v[3]);
                      *(GAS v2u*)(QKL + ((size_t)((bt * 4 + ksq) * 64 + lanep)) * 16 + 8 * hi) = w; } }
          }
          if (tid < 128) { const int d = tid >> 6, t = tid & 63; float* SC = (float*)((unsigned char*)F.out + OUT_SC) + (size_t)(bhc * 2 + d) * SC_FLOATS;
              const float gc = GCN[d * 64 + t], gl = GLs[d], be = BETA[d * 64 + t], rk = RK[t], eg = __expf(gc);
              SC[t] = RQ[t] * eg; SC[64 + t] = rk * __expf(gl - gc); if (t == 0) SC[128] = __expf(gl); SC[160 + t] = be; SC[224 + t] = be * rk * eg; }
        }
    }
    asm volatile("s_waitcnt vmcnt(0)" ::: "memory");
    __syncthreads();
    {
        LAS unsigned char* R = L + wave * 16384;
        for (int k0 = 0; k0 < ((mode & 2) ? 1024 : 0); k0 += 4 * F.G) {
            int lane = lane0; asm volatile("" : "+v"(lane));
            const int r32 = lane & 31, hi = lane >> 5;
            const int u = F.vcu + (wave >> 1) * F.G + k0; const int d = wave & 1;
            if (u < 1024) {
                const int bhc = u;
                const float* LMg = lm_ptr(F, bhc, d); const float* SC = (const float*)((const unsigned char*)F.out + OUT_SC) + (size_t)(bhc * 2 + d) * SC_FLOATS;
                { v4u t[16];
#pragma unroll
                  for (int i = 0; i < 16; ++i) t[i] = *(const GAS v4u*)((const unsigned char*)LMg + (size_t)(i * 64 + lane) * 16);
#pragma unroll
                  for (int i = 0; i < 16; ++i) *(LAS v4u*)(R + (i * 64 + lane) * 16) = t[i]; }
                __builtin_amdgcn_sched_barrier(0);
                const int s = d ? 63 - lane : lane; const float cu = SC[160 + s], cw = SC[224 + s];
                const LAS float* LM = (const LAS float*)R;
                float x[64];
#pragma unroll
                for (int i = 0; i < 64; ++i) x[i] = 0.f;
                f32x4 lpre[8];
#pragma unroll
                for (int j4 = 0; j4 < 8; ++j4) lpre[j4] = (f32x4){0.f, 0.f, 0.f, 0.f};
#pragma unroll
                for (int i = 0; i < 64; ++i) { f32x4 lnext[8], lrest[8];
#pragma unroll
                    for (int j4 = 0; j4 < 8; ++j4) { lnext[j4] = (f32x4){0.f, 0.f, 0.f, 0.f}; if (i + 1 < 64 && j4 < (i + 4) / 4) lnext[j4] = *(const LAS f32x4*)(LM + (i + 1) * 64 + 4 * j4); }
#pragma unroll
                    for (int j4 = 8; j4 < (i + 3) / 4; ++j4) lrest[j4 - 8] = *(const LAS f32x4*)(LM + i * 64 + 4 * j4);
                    float a0 = (lane == i) ? 1.f : 0.f, a1 = 0.f;
#pragma unroll
                    for (int j4 = 0; j4 < (i + 3) / 4; ++j4) { const f32x4 l4 = j4 < 8 ? lpre[j4 & 7] : lrest[(j4 - 8) & 7];
                        a0 = fmaf(-l4.x, x[4 * j4], a0); a1 = fmaf(-l4.y, x[4 * j4 + 1], a1); a0 = fmaf(-l4.z, x[4 * j4 + 2], a0); a1 = fmaf(-l4.w, x[4 * j4 + 3], a1); }
                    x[i] = a0 + a1;
#pragma unroll
                    for (int j4 = 0; j4 < 8; ++j4) lpre[j4] = lnext[j4];
                    __builtin_amdgcn_sched_barrier(0); }
                unsigned char* PD = F.ws + WS_PD + (size_t)(bhc * 2 + d) * PD_BYTES;
                const unsigned char* KTLg = (const unsigned char*)F.out + OUT_PS + (size_t)bhc * PS_BYTES + 16384; const unsigned char* VTFg = vtf_ptr(F, bhc);
                const int sc = s >> 3, sb = (s & 7) * 2;
                int baseK[8];
#pragma unroll
                for (int K = 0; K < 8; ++K) baseK[K] = ((sc ^ K) << 4) + sb;
#define TI_WRITE(T_OF_I) _Pragma("unroll") for (int i = 0; i < 64; ++i) { const int t = (T_OF_I); const unsigned w2 = cvtpk(x[i] * cw, x[i] * cu); \
                    LAS unsigned char* p = R + baseK[(t >> 1) & 7] + t * 128; *(LAS unsigned short*)(p) = (unsigned short)(w2 & 0xffffu); *(LAS unsigned short*)(p + 8192) = (unsigned short)(w2 >> 16); \
                    if ((i & 3) == 3) __builtin_amdgcn_sched_barrier(0); }
                if (d == 0) { TI_WRITE(i) } else { TI_WRITE(63 - i) }
#undef TI_WRITE
                __builtin_amdgcn_sched_barrier(0);
                bf16x8 kf[16];
                int lane_b = lane; asm volatile("" : "+v"(lane_b));
#pragma unroll
                for (int i = 0; i < 16; ++i) kf[i] = *(const GAS bf16x8*)(KTLg + ((size_t)(i * 64 + lane_b)) * 16);
                unsigned char* wp = PD + (size_t)lane * 16;
#pragma unroll
                for (int w = 0; w < 4; ++w) {
#pragma unroll
                    for (int rt = 0; rt < 2; ++rt) { f32x16 acc;
#pragma unroll
                        for (int r = 0; r < 16; ++r) acc[r] = 0.f;
#pragma unroll
                        for (int ks = 0; ks < 4; ++ks) { const bf16x8 bf = *(const LAS bf16x8*)(R + img128(32 * rt + r32, 2 * ks + hi)); acc = MFMA32(kf[w * 4 + ks], bf, acc); }
#pragma unroll
                        for (int ss = 0; ss < 2; ++ss) { v4u o; o.x = pk2(acc[8 * ss], acc[8 * ss + 1]); o.y = pk2(acc[8 * ss + 2], acc[8 * ss + 3]); o.z = pk2(acc[8 * ss + 4], acc[8 * ss + 5]); o.w = pk2(acc[8 * ss + 6], acc[8 * ss + 7]);
                            *(GAS v4u*)(wp) = o; wp += 1024; asm volatile("" : "+v"(wp)); } } }
                __builtin_amdgcn_sched_barrier(0);
                bf16x8 vf[16];
                int lane_c = lane; asm volatile("" : "+v"(lane_c));
#pragma unroll
                for (int i = 0; i < 16; ++i) vf[i] = *(const GAS bf16x8*)(VTFg + ((size_t)(i * 64 + lane_c)) * 16);
                unsigned char* up = PD + 16384 + (size_t)r32 * 128 + 8 * hi;
#pragma unroll
                for (int ct = 0; ct < 4; ++ct) {
#pragma unroll
                    for (int rt = 0; rt < 2; ++rt) { f32x16 acc;
#pragma unroll
                        for (int r = 0; r < 16; ++r) acc[r] = 0.f;
#pragma unroll
                        for (int ks = 0; ks < 4; ++ks) { const bf16x8 af = *(const LAS bf16x8*)(R + 8192 + img128(32 * rt + r32, 2 * ks + hi)); acc = MFMA32(af, vf[ct * 4 + ks], acc); }
#pragma unroll
                        for (int g = 0; g < 4; ++g) { v2u o; o.x = pk2(acc[4 * g], acc[4 * g + 1]); o.y = pk2(acc[4 * g + 2], acc[4 * g + 3]);
                            *(GAS v2u*)(up + rt * 64 + g * 16) = o; }
                        if (rt == 1) { up += 4096; asm volatile("" : "+v"(up)); } } }
            }
        }
    }
}

constexpr int SL_SB = 0, SL_VN = 8192, SL_VS = 12288;
__device__ __forceinline__ void dn_scan_phase(Frame& F) {
    LAS unsigned char* L = F.lds;
    const int lane = F.lane, wave = F.wave, r32 = lane & 31, hi = lane >> 5;
    bf16* OFB = (bf16*)(F.ws + WS_OFB);
    for (int u = F.vcu; u < 256; u += F.G) {
        const int dvs = u & 3, d = (u >> 2) & 1, h = (u >> 3) & 3, b = u >> 5;
        __syncthreads();
        f32x16 S;
#pragma unroll
        for (int r = 0; r < 16; ++r) S[r] = 0.f;
        if (wave < 4) { *(LAS v4u*)(L + SL_SB + ((wave * 2 + 0) * 64 + lane) * 16) = (v4u){0u, 0u, 0u, 0u}; *(LAS v4u*)(L + SL_SB + ((wave * 2 + 1) * 64 + lane) * 16) = (v4u){0u, 0u, 0u, 0u}; }
#define CH_PTRS(nn) const int c_ = d ? 31 - (nn) : (nn), bhc_ = (b * 4 + h) * 32 + c_; \
            const unsigned char* PS = (const unsigned char*)F.out + OUT_PS + (size_t)bhc_ * PS_BYTES; const unsigned char* PD = F.ws + WS_PD + (size_t)(bhc_ * 2 + d) * PD_BYTES; \
            const float* SC = (const float*)((const unsigned char*)F.out + OUT_SC) + (size_t)(bhc_ * 2 + d) * SC_FLOATS; (void)PS; (void)PD; (void)SC;
        if (wave < 4) {
            bf16x8 ktA[4], ktB[4]; float glA, glB;
#define S_LOAD(kt, gl, nn) do { CH_PTRS(nn) _Pragma("unroll") for (int ks = 0; ks < 4; ++ks) kt[ks] = *(const GAS bf16x8*)(PS + 16384 + ((size_t)((wave * 4 + ks) * 64 + lane)) * 16); gl = SC[128]; } while (0)
#define S_STEP(kt, gl) do { BAR_LDS(); BAR_LDS(); _Pragma("unroll") for (int r = 0; r < 16; ++r) S[r] *= gl; \
                _Pragma("unroll") for (int ks = 0; ks < 4; ++ks) { const bf16x8 vs = *(const LAS bf16x8*)(L + SL_VS + (ks * 64 + lane) * 16); S = MFMA32(kt[ks], vs, S); } \
                *(LAS bf16x8*)(L + SL_SB + ((wave * 2 + 0) * 64 + lane) * 16) = pack8(S, 0); *(LAS bf16x8*)(L + SL_SB + ((wave * 2 + 1) * 64 + lane) * 16) = pack8(S, 1); } while (0)
            S_LOAD(ktA, glA, 0);
#pragma unroll 1
            for (int n = 0; n < 32; n += 2) { S_LOAD(ktB, glB, n + 1); S_STEP(ktA, glA); if (n + 2 < 32) S_LOAD(ktA, glA, n + 2); S_STEP(ktB, glB); }
#undef S_LOAD
#undef S_STEP
        } else if (wave < 6) {
            const int rt = wave - 4;
            bf16x8 wlA[8], wlB[8]; v2u utA[4], utB[4]; f32x4 kscA[4], kscB[4];
#define V_LOAD(wl, ut, ksc, nn) do { CH_PTRS(nn) _Pragma("unroll") for (int i = 0; i < 8; ++i) wl[i] = *(const GAS bf16x8*)(PD + ((size_t)((((i >> 1) * 2 + rt) * 2 + (i & 1)) * 64 + lane)) * 16); \
                _Pragma("unroll") for (int g = 0; g < 4; ++g) { ut[g] = *(const GAS v2u*)(PD + 16384 + (size_t)(32 * dvs + r32) * 128 + (32 * rt + 8 * g + 4 * hi) * 2); ksc[g] = *(const GAS f32x4*)(SC + 64 + 32 * rt + 8 * g + 4 * hi); } } while (0)
#define V_STEP(wl, ut, ksc) do { BAR_LDS(); f32x16 acc; _Pragma("unroll") for (int r = 0; r < 16; ++r) acc[r] = 0.f; \
                _Pragma("unroll") for (int i = 0; i < 8; ++i) { const bf16x8 sb = *(const LAS bf16x8*)(L + SL_SB + (i * 64 + lane) * 16); acc = MFMA32(wl[i], sb, acc); } \
                _Pragma("unroll") for (int g = 0; g < 4; ++g) { const float u0 = bflo(ut[g].x) - acc[4 * g], u1 = bfhi(ut[g].x) - acc[4 * g + 1], u2 = bflo(ut[g].y) - acc[4 * g + 2], u3 = bfhi(ut[g].y) - acc[4 * g + 3]; \
                    const int off = ((2 * rt + (g >> 1)) * 64 + r32 + 32 * (g & 1)) * 16 + 8 * hi; \
                    v2u a; a.x = cvtpk(u0, u1); a.y = cvtpk(u2, u3); *(LAS v2u*)(L + SL_VN + off) = a; \
                    v2u s2; s2.x = cvtpk(u0 * ksc[g].x, u1 * ksc[g].y); s2.y = cvtpk(u2 * ksc[g].z, u3 * ksc[g].w); *(LAS v2u*)(L + SL_VS + off) = s2; } \
                BAR_LDS(); } while (0)
            V_LOAD(wlA, utA, kscA, 0);
#pragma unroll 1
            for (int n = 0; n < 32; n += 2) { V_LOAD(wlB, utB, kscB, n + 1); V_STEP(wlA, utA, kscA); if (n + 2 < 32) V_LOAD(wlA, utA, kscA, n + 2); V_STEP(wlB, utB, kscB); }
#undef V_LOAD
#undef V_STEP
        } else {
            const int rt = wave - 6;
            bf16x8 qlA[8], qlB[8], qkA[4], qkB[4]; f32x4 rscA[4], rscB[4];
#define O_LOAD(ql, qk, rsc, nn) do { CH_PTRS(nn) _Pragma("unroll") for (int i = 0; i < 8; ++i) ql[i] = *(const GAS bf16x8*)(PS + ((size_t)((((i >> 1) * 2 + rt) * 2 + (i & 1)) * 64 + lane)) * 16); \
                _Pragma("unroll") for (int ks = 0; ks < 4; ++ks) qk[ks] = *(const GAS bf16x8*)(PD + 32768 + ((size_t)((rt * 4 + ks) * 64 + lane)) * 16); \
                _Pragma("unroll") for (int g = 0; g < 4; ++g) rsc[g] = *(const GAS f32x4*)(SC + 32 * rt + 8 * g + 4 * hi); } while (0)
#define O_STEP(ql, qk, rsc, nn) do { BAR_LDS(); f32x16 acc; _Pragma("unroll") for (int r = 0; r < 16; ++r) acc[r] = 0.f; \
                _Pragma("unroll") for (int i = 0; i < 8; ++i) { const bf16x8 sb = *(const LAS bf16x8*)(L + SL_SB + (i * 64 + lane) * 16); acc = MFMA32(ql[i], sb, acc); } \
                _Pragma("unroll") for (int g = 0; g < 4; ++g) { acc[4 * g] *= rsc[g].x; acc[4 * g + 1] *= rsc[g].y; acc[4 * g + 2] *= rsc[g].z; acc[4 * g + 3] *= rsc[g].w; } \
                BAR_LDS(); \
                _Pragma("unroll") for (int ks = 0; ks < 4; ++ks) { const bf16x8 vn = *(const LAS bf16x8*)(L + SL_VN + (ks * 64 + lane) * 16); acc = MFMA32(qk[ks], vn, acc); } \
                { const int c2 = d ? 31 - (nn) : (nn); bf16* op = OFB + ((size_t)d * M + (size_t)b * 2048 + 64 * c2 + 32 * rt) * 512 + h * 128 + 32 * dvs + r32; \
                _Pragma("unroll") for (int r = 0; r < 16; ++r) op[(size_t)crow(r, hi) * 512] = (bf16)f2bf(acc[r]); } } while (0)
            O_LOAD(qlA, qkA, rscA, 0);
#pragma unroll 1
            for (int n = 0; n < 32; n += 2) { O_LOAD(qlB, qkB, rscB, n + 1); O_STEP(qlA, qkA, rscA, n); if (n + 2 < 32) O_LOAD(qlA, qkA, rscA, n + 2); O_STEP(qlB, qkB, rscB, n + 1); }
#undef O_LOAD
#undef O_STEP
        }
#undef CH_PTRS
    }
}
namespace simple {
__device__ __forceinline__ float wmax(float v) {
#pragma unroll
    for (int o = 1; o < 64; o <<= 1) v = fmaxf(v, __shfl_xor(v, o));
    return v;
}
__global__ void __launch_bounds__(256) wattn_k(const bf16* __restrict__ QA, const bf16* __restrict__ KA, const bf16* __restrict__ VA, const float* __restrict__ sink, bf16* __restrict__ mix) {
    __shared__ float pbuf[4][320];
    __shared__ float qbuf[4][64];
    const int w = threadIdx.x >> 6, lane = threadIdx.x & 63;
    const int item = blockIdx.x * 4 + w, tok = item >> 3, hq = item & 7, kvh = hq >> 2;
    const int b = tok / SEQ, i = tok % SEQ;
    qbuf[w][lane] = bf2f(QA[(size_t)tok * 512 + hq * 64 + lane]);
    __syncthreads();
    const int jlo = i - 128; const float sinkl = sink[hq] * LOG2E;
    float sc[5]; float mx = sinkl;
#pragma unroll
    for (int r = 0; r < 5; ++r) { const int jj = lane + 64 * r, j = jlo + jj; sc[r] = -INFINITY;
        if (jj <= 256 && j >= 0 && j < SEQ) { const bf16* kp = KA + (size_t)(b * SEQ + j) * 128 + kvh * 64; float s = 0.f;
            for (int d = 0; d < 64; ++d) s = fmaf(qbuf[w][d], bf2f(kp[d]), s);
            sc[r] = s; mx = fmaxf(mx, s); } }
    mx = wmax(mx);
    float den = 0.f;
#pragma unroll
    for (int r = 0; r < 5; ++r) { const int jj = lane + 64 * r; const float p = (sc[r] == -INFINITY) ? 0.f : exp2f(sc[r] - mx); if (jj < 320) pbuf[w][jj] = p; den += p; }
    den = wave_sum(den) + exp2f(sinkl - mx);
    __syncthreads();
    float o = 0.f;
    for (int jj = 0; jj <= 256; ++jj) { const int j = jlo + jj; if (j >= 0 && j < SEQ) o = fmaf(pbuf[w][jj], bf2f(VA[(size_t)(b * SEQ + j) * 128 + kvh * 64 + lane]), o); }
    mix[(size_t)tok * D + hq * 64 + lane] = (bf16)f2bf(o / den);
}
__global__ void __launch_bounds__(128) dn_k(const bf16* __restrict__ DQ, const float* __restrict__ conv_w, const float* __restrict__ gb, bf16* __restrict__ O) {
    __shared__ __attribute__((aligned(16))) float sk[128];
    __shared__ __attribute__((aligned(16))) float sq[128];
    __shared__ float red[2][2];
    const int j = threadIdx.x, blk = blockIdx.x, dir = blk & 1, h = (blk >> 1) & 3, b = blk >> 3;
    const int cq = h * 128 + j, ck = cq + 512, cv = cq + 1024;
    float wq[5], wk[5], wv[5];
#pragma unroll
    for (int w = 0; w < 5; ++w) { wq[w] = conv_w[w * 1536 + cq]; wk[w] = conv_w[w * 1536 + ck]; wv[w] = conv_w[w * 1536 + cv]; }
    const float* gp = gb + ((size_t)(dir * 8 + b) * 4 + h) * 2048; const float* bp = gp + 131072;
    float St[128];
#pragma unroll
    for (int i = 0; i < 128; ++i) St[i] = 0.f;
    for (int step = 0; step < SEQ; ++step) {
        const int t = dir ? (SEQ - 1 - step) : step;
        float q = 0.f, k = 0.f, v = 0.f;
#pragma unroll
        for (int w = 0; w < 5; ++w) { const int tt = t + w - 2; if (tt >= 0 && tt < SEQ) { const bf16* r2 = DQ + (size_t)(b * SEQ + tt) * 1536; q = fmaf(bf2f(r2[cq]), wq[w], q); k = fmaf(bf2f(r2[ck]), wk[w], k); v = fmaf(bf2f(r2[cv]), wv[w], v); } }
        q = q / (1.f + expf(-q)); k = k / (1.f + expf(-k)); v = v / (1.f + expf(-v));
        const float e = expf(gp[t]), beta = bp[t];
        float s1 = wave_sum(q * q), s2 = wave_sum(k * k);
        if ((j & 63) == 0) { red[j >> 6][0] = s1; red[j >> 6][1] = s2; }
        __syncthreads();
        const float ssq = red[0][0] + red[1][0], ssk = red[0][1] + red[1][1];
        sq[j] = q * rsqrtf(ssq + EPS) * 0.08838834764831845f; sk[j] = k * rsqrtf(ssk + EPS);
        __syncthreads();
        float dot = 0.f;
#pragma unroll
        for (int i4 = 0; i4 < 32; ++i4) { const float4 kk = ((const float4*)sk)[i4]; dot = fmaf(kk.x, St[4 * i4], dot); dot = fmaf(kk.y, St[4 * i4 + 1], dot); dot = fmaf(kk.z, St[4 * i4 + 2], dot); dot = fmaf(kk.w, St[4 * i4 + 3], dot); }
        const float c = beta * (v - e * dot);
        float o = 0.f;
#pragma unroll
        for (int i4 = 0; i4 < 32; ++i4) { const float4 kk = ((const float4*)sk)[i4]; const float4 qq = ((const float4*)sq)[i4];
            St[4 * i4] = fmaf(e, St[4 * i4], kk.x * c); o = fmaf(qq.x, St[4 * i4], o);
            St[4 * i4 + 1] = fmaf(e, St[4 * i4 + 1], kk.y * c); o = fmaf(qq.y, St[4 * i4 + 1], o);
            St[4 * i4 + 2] = fmaf(e, St[4 * i4 + 2], kk.z * c); o = fmaf(qq.z, St[4 * i4 + 2], o);
            St[4 * i4 + 3] = fmaf(e, St[4 * i4 + 3], kk.w * c); o = fmaf(qq.w, St[4 * i4 + 3], o); }
        O[((size_t)dir * M + (size_t)(b * SEQ + t)) * 512 + h * 128 + j] = (bf16)f2bf(o);
    }
}
__global__ void __launch_bounds__(256) cattn_k(const bf16* __restrict__ QC, const bf16* __restrict__ KC, const bf16* __restrict__ VCT, bf16* __restrict__ OC) {
    __shared__ float qb[4][256];
    __shared__ float pb[4][256];
    const int w = threadIdx.x >> 6, lane = threadIdx.x & 63;
    const int item = blockIdx.x * 4 + w, tok = item >> 2, hd = item & 3, b = tok / SEQ;
    for (int i = 0; i < 4; ++i) qb[w][lane + 64 * i] = bf2f(QC[(size_t)tok * D + hd * 256 + lane + 64 * i]);
    __syncthreads();
    float sc[4], mx = -INFINITY;
#pragma unroll
    for (int r = 0; r < 4; ++r) { const int key = lane + 64 * r; const bf16* kp = KC + (size_t)(b * MEMLEN + key) * 1024 + hd * 256; float s = 0.f;
        for (int d = 0; d < 256; ++d) s = fmaf(qb[w][d], bf2f(kp[d]), s);
        sc[r] = s; mx = fmaxf(mx, s); }
    mx = wmax(mx);
    float den = 0.f;
#pragma unroll
    for (int r = 0; r < 4; ++r) { const float p = exp2f(sc[r] - mx); pb[w][lane + 64 * r] = p; den += p; }
    den = wave_sum(den);
    __syncthreads();
#pragma unroll
    for (int r = 0; r < 4; ++r) { const int d = lane + 64 * r; const bf16* vp = VCT + (size_t)(hd * 256 + d) * 2048 + b * MEMLEN; float acc = 0.f;
        for (int key = 0; key < 256; ++key) acc = fmaf(pb[w][key], bf2f(vp[key]), acc);
        OC[(size_t)tok * D + hd * 256 + d] = (bf16)f2bf(acc / den); }
}
}
__global__ void __launch_bounds__(NWAVES * 64, 2) mk_fwd(Args args) {
    extern __shared__ __attribute__((aligned(16))) unsigned char lds[];
    Frame F;
    F.lds = (LAS unsigned char*)lds; F.MISC = (volatile LAS unsigned*)(F.lds + MISC_OFF);
    F.tid = threadIdx.x; F.lane = F.tid & 63; F.wave = __builtin_amdgcn_readfirstlane(F.tid >> 6);
    F.G = gridDim.x; { const int bx = blockIdx.x; F.vcu = (F.G % 8 == 0) ? (bx % 8) * (F.G / 8) + bx / 8 : bx; }
    F.ws = args.ws; F.out = args.out; F.ctl = (gu32*)(args.ws + WS_CTL);
    for (int u = F.tid; u < (LDS_BYTES - LDSCTL_OFF) / 4; u += NWAVES * 64) ((LAS unsigned*)(F.lds + LDSCTL_OFF))[u] = 0u;
    __syncthreads();
    const int lo = args.ph_lo, hi = args.ph_hi;
    XcdBarrier bar; bar.bar = (unsigned*)(F.ctl + CW_BAR); bar.x = 0; bar.st = nullptr;
    if (hi - lo > 1) bar = xcd_barrier_post((unsigned*)(F.ctl + CW_BAR), F.MISC + 8);
#define IN(k) (lo <= (k) && (k) < hi)
#define SEAM(k) do { if (IN(k) && IN((k) + 1)) xcd_barrier(bar); } while (0)
#ifndef PROBE_DUP
#define PROBE_DUP -1
#endif
#define PHASE(k, ...) do { if (IN(k)) { __VA_ARGS__ if (PROBE_DUP == (k)) { xcd_barrier(bar); __VA_ARGS__ } } } while (0)
    unsigned char* ws = args.ws;
    PHASE(0, p0_prologue(F, args); ); SEAM(0);
    PHASE(1, pg8::Gemm g{(const pg8::bf16_t*)(ws + WS_REG1), (const pg8::bf16_t*)(ws + WS_REG1), 0, 0, D}; SchedP1 S{F.G, (int)blockIdx.x}; EpiP1 E{ws};
        pg8::gemm_phase<EpiP1, SchedP1, true, true>(F.lds + RING_OFF, g, S, E); ); SEAM(1);
    PHASE(2, window_attn_phase(F, (const float*)args.in[9]); dn_prep_phase(F, (const float*)args.in[5]); );
    if (PROBE_DUP == 20) { xcd_barrier(bar); window_attn_phase(F, (const float*)args.in[9]); } if (PROBE_DUP == 21) { xcd_barrier(bar); dn_prep_phase(F, (const float*)args.in[5]); } if (PROBE_DUP == 22) { xcd_barrier(bar); dn_prep_phase(F, (const float*)args.in[5], 1); } if (PROBE_DUP == 23) { xcd_barrier(bar); dn_prep_phase(F, (const float*)args.in[5], 2); }
    SEAM(2);
    PHASE(3, dn_scan_phase(F); ); SEAM(3);
    PHASE(4, dn_combine(F, (const float*)args.in[8]); ); SEAM(4);
    PHASE(5, pg8::Gemm g{(const pg8::bf16_t*)(ws + WS_MIX), (const pg8::bf16_t*)(ws + WS_WOUT), M, D, D}; pg8::StaticOrder S; S.init(M, D, F.G, (int)blockIdx.x); EpiPlain E{(bf16*)(ws + WS_MIXO), D, 1.f};
        pg8::gemm_phase<EpiPlain, pg8::StaticOrder, true, true>(F.lds + RING_OFF, g, S, E); ); SEAM(5);
    PHASE(6, row_pass<0>(F, args.in[0], (const bf16*)(ws + WS_MIXO), (const float*)args.in[11], (bf16*)(ws + WS_REG1), (float*)(ws + WS_RS), nullptr); ); SEAM(6);
    PHASE(7, pg8::Gemm g{(const pg8::bf16_t*)(ws + WS_REG1), (const pg8::bf16_t*)(ws + WS_WCQ), M, D, D}; pg8::StaticOrder S; S.init(M, D, F.G, (int)blockIdx.x); EpiRowScale E{(bf16*)(ws + WS_QC), D, QSCALE_C, (const float*)(ws + WS_RS)};
        pg8::gemm_phase<EpiRowScale, pg8::StaticOrder, true, true>(F.lds + RING_OFF, g, S, E); ); SEAM(7);
    PHASE(8, cross_attn_phase(F); ); SEAM(8);
    PHASE(9, pg8::Gemm g{(const pg8::bf16_t*)(ws + WS_OC), (const pg8::bf16_t*)(ws + WS_WCO), M, D, D}; pg8::StaticOrder S; S.init(M, D, F.G, (int)blockIdx.x); EpiPlain E{(bf16*)(ws + WS_CC), D, 1.f};
        pg8::gemm_phase<EpiPlain, pg8::StaticOrder, true, true>(F.lds + RING_OFF, g, S, E); ); SEAM(9);
    PHASE(10, row_pass<1>(F, (const void*)(ws + WS_REG1), (const bf16*)(ws + WS_CC), (const float*)args.in[17], (bf16*)(ws + WS_REG1), (float*)(ws + WS_RS) + M, nullptr); ); SEAM(10);
    PHASE(11, pg8::Gemm g{(const pg8::bf16_t*)(ws + WS_REG1), (const pg8::bf16_t*)(ws + WS_WGU), M, 2 * DFF, D}; pg8::StaticOrder S; S.init(M, 2 * DFF, F.G, (int)blockIdx.x); EpiSwiglu E{(bf16*)(ws + WS_ACT), (const float*)(ws + WS_RS) + M};
        pg8::gemm_phase<EpiSwiglu, pg8::StaticOrder, true, true>(F.lds + RING_OFF, g, S, E); ); SEAM(11);
    PHASE(12, pg8::Gemm g{(const pg8::bf16_t*)(ws + WS_ACT), (const pg8::bf16_t*)(ws + WS_WDOWN), M, D, DFF}; pg8::StaticOrder S; S.init(M, D, F.G, (int)blockIdx.x); EpiPlain E{(bf16*)(ws + WS_FF), D, 1.f};
        pg8::gemm_phase<EpiPlain, pg8::StaticOrder, true, true>(F.lds + RING_OFF, g, S, E); ); SEAM(12);
    if (IN(13)) { row_pass<2>(F, (const void*)(ws + WS_REG1), (const bf16*)(ws + WS_FF), (const float*)args.in[21], nullptr, nullptr, F.out); }
    if (PROBE_DUP == 100) { for (int q = 0; q < 10; ++q) xcd_barrier(bar); }
#undef IN
#undef SEAM
}

extern "C" void kernel_launch(void* const* d_in, const int* in_sizes, int n_in, void* d_out, int out_size, void* d_ws, size_t ws_size, hipStream_t stream) {
    static int grid = 0;
    if (grid == 0) {
        int dev = 0, cus = 0;
        if (hipGetDevice(&dev) != hipSuccess || hipDeviceGetAttribute(&cus, hipDeviceAttributeMultiprocessorCount, dev) != hipSuccess) { fprintf(stderr, "kernel_launch: device query failed\n"); grid = -1; return; }
        if (hipFuncSetAttribute((const void*)mk_fwd, hipFuncAttributeMaxDynamicSharedMemorySize, LDS_BYTES) != hipSuccess) { fprintf(stderr, "kernel_launch: hipFuncSetAttribute failed\n"); grid = -1; return; }
        (void)hipGetLastError();
        grid = cus;
        if (ws_size < WS_END) { fprintf(stderr, "kernel_launch: workspace too small\n"); grid = -1; return; }
    }
    if (grid < 0) return;
    (void)hipMemsetAsync((char*)d_ws + WS_CTL, 0, CTL_ZERO_BYTES, stream);
    Args a{};
    for (int i = 0; i < 22; ++i) a.in[i] = d_in[i];
    a.out = (float*)d_out; a.ws = (unsigned char*)d_ws;
    auto mk = [&](int lo, int hi) { a.ph_lo = lo; a.ph_hi = hi; hipLaunchKernelGGL(mk_fwd, dim3(grid), dim3(NWAVES * 64), LDS_BYTES, stream, a); };
    mk(0, 14);
}
```
